# Optimizing an MI355X kernel written in HIP

```python
import jax, jax.numpy as jnp
from jax import lax
import numpy as np

D_MODEL = 1024
BATCH = 1
SEQ = 16384
DEPTH = 4

MLA_HEADS = 8
QK_NOPE_DIM = 64
QK_ROPE_DIM = 32
V_HEAD_DIM = 64
Q_LORA_RANK = 384
KV_LORA_RANK = 256
ROPE_THETA = 10000.0
Q_BLOCK = 128
SG_GROUPS = 8
SG_GROUP_DIM = 64
SG_WIDTH = SG_GROUPS * SG_GROUP_DIM
SG_CHUNK = 128
CONV_WIDTH = D_MODEL
CONV_K = 3
D_FF = 2816
NORM_EPS = 1e-6

MLA_OUT = MLA_HEADS * V_HEAD_DIM
MIX_WIDTH = MLA_OUT + SG_WIDTH
QK_HEAD_DIM = QK_NOPE_DIM + QK_ROPE_DIM
EVEN_IN = Q_LORA_RANK + KV_LORA_RANK + QK_ROPE_DIM + 2 * SG_WIDTH
N_EVEN = (DEPTH + 1) // 2
N_ODD = DEPTH // 2

kernel_name = "macaron_mla_sgu_shortconv_hybrid"


def rms_norm(x, g):
    x32 = x.astype(jnp.float32)
    y = x32 * lax.rsqrt(jnp.mean(x32 * x32, axis=-1, keepdims=True) + NORM_EPS)
    return (y * g.astype(jnp.float32)).astype(x.dtype)


def swiglu(h, w_gate, w_up, w_down):
    return (jax.nn.silu(h @ w_gate) * (h @ w_up)) @ w_down


def rope_tables(positions):
    inv_freq = ROPE_THETA ** (-jnp.arange(0, QK_ROPE_DIM, 2, dtype=jnp.float32) / QK_ROPE_DIM)
    ang = positions.astype(jnp.float32)[..., None] * inv_freq
    return jnp.cos(ang), jnp.sin(ang)


def apply_rope(t, cos, sin):
    t32 = t.astype(jnp.float32)
    t1, t2 = jnp.split(t32, 2, axis=-1)
    out = jnp.concatenate([t1 * cos - t2 * sin, t1 * sin + t2 * cos], axis=-1)
    return out.astype(t.dtype)


def mla_attention(q_nope, q_rope, k_nope, k_rope, v):
    B, S, H, _ = q_nope.shape
    nb = S // Q_BLOCK
    scale = QK_HEAD_DIM ** -0.5
    k_idx = jnp.arange(S)

    def to_blocks(t):
        return jnp.moveaxis(t.reshape(B, nb, Q_BLOCK, *t.shape[2:]), 1, 0)

    def one_block(args):
        qn, qr, i = args
        s = (jnp.einsum('bqhd,bkhd->bhqk', qn, k_nope, preferred_element_type=jnp.float32)
             + jnp.einsum('bqhr,bkr->bhqk', qr, k_rope, preferred_element_type=jnp.float32)) * scale
        q_idx = i * Q_BLOCK + jnp.arange(Q_BLOCK)
        s = jnp.where(k_idx[None, :] <= q_idx[:, None], s, -jnp.inf)
        p = jax.nn.softmax(s, axis=-1).astype(v.dtype)
        return jnp.einsum('bhqk,bkhd->bqhd', p, v)

    out = lax.map(one_block, (to_blocks(q_nope), to_blocks(q_rope), jnp.arange(nb)))
    return jnp.moveaxis(out, 0, 1).reshape(B, S, H * V_HEAD_DIM)


def spatial_gating(z, sg_norm, sg_w, sg_b):
    u, v = jnp.split(z, 2, axis=-1)
    v = rms_norm(v, sg_norm)
    B, S, _ = v.shape
    nc = S // SG_CHUNK
    v = v.reshape(B, nc, SG_CHUNK, SG_GROUPS, SG_GROUP_DIM)
    w = sg_w * jnp.tril(jnp.ones((SG_CHUNK, SG_CHUNK), dtype=sg_w.dtype))
    mixed = jnp.einsum('gts,bnsgc->bntgc', w, v) + sg_b.T[None, None, :, :, None]
    return u * mixed.reshape(B, S, SG_WIDTH)


def mla_sgu_mixer(h, cos, sin, w_in, q_norm, w_uq, kv_norm, w_ukv, sg_norm, sg_w, sg_b, w_out):
    B, S, _ = h.shape
    proj = h @ w_in
    c_q, c_kv, k_rope, z = jnp.split(
        proj, [Q_LORA_RANK, Q_LORA_RANK + KV_LORA_RANK, Q_LORA_RANK + KV_LORA_RANK + QK_ROPE_DIM], axis=-1)
    q = (rms_norm(c_q, q_norm) @ w_uq).reshape(B, S, MLA_HEADS, QK_HEAD_DIM)
    q_nope = q[..., :QK_NOPE_DIM]
    q_rope = apply_rope(q[..., QK_NOPE_DIM:], cos[:, :, None, :], sin[:, :, None, :])
    k_rope = apply_rope(k_rope, cos, sin)
    kv = (rms_norm(c_kv, kv_norm) @ w_ukv).reshape(B, S, MLA_HEADS, QK_NOPE_DIM + V_HEAD_DIM)
    k_nope, v = kv[..., :QK_NOPE_DIM], kv[..., QK_NOPE_DIM:]
    attn = mla_attention(q_nope, q_rope, k_nope, k_rope, v)
    sg = spatial_gating(jax.nn.gelu(z, approximate=False), sg_norm, sg_w, sg_b)
    return jnp.concatenate([attn, sg], axis=-1) @ w_out


def short_conv_mixer(h, w_in, conv_w, w_out):
    b_gate, c_gate, z = jnp.split(h @ w_in, 3, axis=-1)
    y = lax.conv_general_dilated(
        c_gate * z, conv_w[:, None, :], window_strides=(1,), padding=[(CONV_K - 1, 0)],
        dimension_numbers=('NWC', 'WIO', 'NWC'), feature_group_count=CONV_WIDTH)
    return (b_gate * y) @ w_out


def setup_inputs(seed: int = 0) -> dict:
    key = jax.random.key(seed)
    keys = iter(jax.random.split(key, 32))
    f32 = jnp.float32

    def dense(shape, fan_in):
        return jax.random.normal(next(keys), shape, f32) * (fan_in ** -0.5)

    def gain(shape):
        return 1.0 + 0.1 * jax.random.normal(next(keys), shape, f32)

    x = jax.random.normal(next(keys), (BATCH, SEQ, D_MODEL), f32)
    offset = jax.random.randint(next(keys), (BATCH, 1), 0, 1024, dtype=jnp.int32)
    positions = offset + jnp.arange(SEQ, dtype=jnp.int32)[None, :]
    return {
        "x": x,
        "positions": positions,
        "ffn_pre_norm": gain((DEPTH, D_MODEL)),
        "ffn_pre_w_gate": dense((DEPTH, D_MODEL, D_FF), D_MODEL),
        "ffn_pre_w_up": dense((DEPTH, D_MODEL, D_FF), D_MODEL),
        "ffn_pre_w_down": dense((DEPTH, D_FF, D_MODEL), D_FF),
        "mix_norm": gain((DEPTH, D_MODEL)),
        "ffn_post_norm": gain((DEPTH, D_MODEL)),
        "ffn_post_w_gate": dense((DEPTH, D_MODEL, D_FF), D_MODEL),
        "ffn_post_w_up": dense((DEPTH, D_MODEL, D_FF), D_MODEL),
        "ffn_post_w_down": dense((DEPTH, D_FF, D_MODEL), D_FF),
        "even_w_in": dense((N_EVEN, D_MODEL, EVEN_IN), D_MODEL),
        "q_norm": gain((N_EVEN, Q_LORA_RANK)),
        "w_uq": dense((N_EVEN, Q_LORA_RANK, MLA_HEADS * QK_HEAD_DIM), Q_LORA_RANK),
        "kv_norm": gain((N_EVEN, KV_LORA_RANK)),
        "w_ukv": dense((N_EVEN, KV_LORA_RANK, MLA_HEADS * (QK_NOPE_DIM + V_HEAD_DIM)), KV_LORA_RANK),
        "sg_norm": gain((N_EVEN, SG_WIDTH)),
        "sg_w": dense((N_EVEN, SG_GROUPS, SG_CHUNK, SG_CHUNK), SG_CHUNK),
        "sg_b": gain((N_EVEN, SG_GROUPS, SG_CHUNK)),
        "even_w_out": dense((N_EVEN, MIX_WIDTH, D_MODEL), MIX_WIDTH),
        "conv_w_in": dense((N_ODD, D_MODEL, 3 * CONV_WIDTH), D_MODEL),
        "conv_w": dense((N_ODD, CONV_K, CONV_WIDTH), CONV_K),
        "conv_w_out": dense((N_ODD, CONV_WIDTH, D_MODEL), CONV_WIDTH),
        "final_norm": gain((D_MODEL,)),
    }


def reference(x, positions, ffn_pre_norm, ffn_pre_w_gate, ffn_pre_w_up, ffn_pre_w_down,
              mix_norm, ffn_post_norm, ffn_post_w_gate, ffn_post_w_up, ffn_post_w_down,
              even_w_in, q_norm, w_uq, kv_norm, w_ukv, sg_norm, sg_w, sg_b, even_w_out,
              conv_w_in, conv_w, conv_w_out, final_norm):
    cos, sin = rope_tables(positions)
    for layer in range(DEPTH):
        x = x + 0.5 * swiglu(rms_norm(x, ffn_pre_norm[layer]),
                             ffn_pre_w_gate[layer], ffn_pre_w_up[layer], ffn_pre_w_down[layer])
        h = rms_norm(x, mix_norm[layer])
        if layer % 2 == 0:
            e = layer // 2
            x = x + mla_sgu_mixer(h, cos, sin, even_w_in[e], q_norm[e], w_uq[e], kv_norm[e],
                                  w_ukv[e], sg_norm[e], sg_w[e], sg_b[e], even_w_out[e])
        else:
            o = layer // 2
            x = x + short_conv_mixer(h, conv_w_in[o], conv_w[o], conv_w_out[o])
        x = x + 0.5 * swiglu(rms_norm(x, ffn_post_norm[layer]),
                             ffn_post_w_gate[layer], ffn_post_w_up[layer], ffn_post_w_down[layer])
    return rms_norm(x, final_norm)
```

```cpp
#include <hip/hip_runtime.h>
#include <hip/hip_cooperative_groups.h>
#include <cstdio>
#include <cstdint>
#include <cmath>
namespace cg = cooperative_groups;
namespace pg8 {
#define PG8_LAS __attribute__((address_space(3)))
typedef unsigned short bf16_t;
typedef short bf16x8 __attribute__((ext_vector_type(8)));
typedef float f32x4 __attribute__((ext_vector_type(4)));
typedef unsigned u32x4 __attribute__((ext_vector_type(4)));
constexpr int BM = 256, BK = 64, HALF = 128, HTB = HALF * BK * 2  , STAGE_BYTES = 8 * HTB, NXCD = 8, WGM = 8;

__host__ __device__ __forceinline__ int lds_byte(int r, int c) { const int st = (r >> 4) * 2 + (c >> 5), rr = r & 15, cc = c & 31, ob = rr * 64 + cc * 2; return st * 1024 + (ob ^ (((ob >> 9) & 1) << 5)); }
__host__ __device__ __forceinline__ void stage_rc(int b, int& R, int& C) { const int st = b / 1024, sb = b % 1024, swz = sb ^ (((sb >> 9) & 1) << 5); R = (st >> 1) * 16 + swz / 64; C = (st & 1) * 32 + (swz % 64) / 2; }
__host__ __device__ __forceinline__ int perm32(int rho) { const int n = rho >> 4, i = rho & 15; return 8 * (i >> 2) + 4 * n + (i & 3); }

struct Unit { int pm, pn; };
struct Gemm { const bf16_t* A; const bf16_t* Bt; int M, N, K, lda, ldb; };

struct StaticOrder {
    int nM, nN, nwg, G, c;
    __host__ __device__ void init(int M, int N, int G_, int c_) { nM = M / BM; nN = N / BM; nwg = nM * nN; G = G_; c = c_; }
    __host__ __device__ bool next(int i, Unit& u) const {
        const long L = (long)i * G + c; if (L >= nwg) return false;
        int wgid = (int)L; { const int q = nwg / NXCD, r = nwg % NXCD, xcd = wgid % NXCD, off = wgid / NXCD; wgid = (xcd < r ? xcd * (q + 1) : r * (q + 1) + (xcd - r) * q) + off; }
        const int nig = WGM * nN, gid = wgid / nig, fm = gid * WGM, gsz = (nM - fm) < WGM ? (nM - fm) : WGM;
        u.pm = fm + ((wgid % nig) % gsz); u.pn = (wgid % nig) / gsz; return true;
    }
    __device__ __forceinline__ void a_ready(const Unit&) const {}
    __device__ __forceinline__ void done(const Unit&) const {}
};

__device__ __forceinline__ unsigned cvt_pk_bf16(float lo, float hi) { unsigned r; asm volatile("v_cvt_pk_bf16_f32 %0, %1, %2" : "=v"(r) : "v"(lo), "v"(hi)); return r; }
typedef float f32x2 __attribute__((ext_vector_type(2)));
__device__ __forceinline__ f32x2 gelu_pk(f32x2 v) {
    const f32x2 av = __builtin_elementwise_abs(v), d = av * 0.2316418882f + 1.0f;
    f32x2 t; t.x = __builtin_amdgcn_rcpf(d.x); t.y = __builtin_amdgcn_rcpf(d.y);
    f32x2 q = t * 0.5307027145f + (-0.7265760135f); q = q * t + 0.7107068705f; q = q * t + (-0.142248368f); q = q * t + 0.127414796f; q = q * t;
    const f32x2 s = (v * v) * (-0.72134752044f);
    f32x2 e; e.x = __builtin_amdgcn_exp2f(s.x); e.y = __builtin_amdgcn_exp2f(s.y);
    const f32x2 m = v * (q * e), r = v - m;
    f32x2 o; o.x = v.x < 0.f ? m.x : r.x; o.y = v.y < 0.f ? m.y : r.y; return o;
}
template <class Epi, class Sched, bool ALIGN_EPI = false, bool SP2 = false>
__device__ __forceinline__ void gemm_phase(PG8_LAS unsigned char* lds, const Gemm g, const Sched& S, const Epi& E) {
    int tid_l = threadIdx.x; asm volatile("" : "+v"(tid_l)); const int tid = tid_l, wid = __builtin_amdgcn_readfirstlane(tid >> 6), lane = tid & 63, wr = wid >> 2, wc = wid & 3, fr = lane & 15, fq = lane >> 4;
    const int K = g.K, nt = K / BK;
    unsigned voffA[2], voffB[2];
#pragma unroll
    for (int i = 0; i < 2; ++i) { int R, C; stage_rc(tid * 16 + i * 8192, R, C); const int Rb = Epi::PERM ? ((R & ~31) + perm32(R & 31)) : R;
        voffA[i] = (unsigned)(R * g.lda + C) * 2u; voffB[i] = (unsigned)(Rb * g.ldb + C) * 2u; }
    const size_t kstep = (size_t)(BK * 2);
    const size_t hstepA = (size_t)HALF * g.lda * 2, hstepB = (size_t)HALF * g.ldb * 2;
    const size_t tstepA = 2 * hstepA, tstepB = 2 * hstepB;
    const unsigned ldsw = (unsigned)wid * 1024u;
    const int aoff = lds_byte(wr * 64 + fr, fq * 8), boff = lds_byte(wc * 32 + fr, fq * 8);
#define PG8_SA(b, h) (((b) * 2 + (h)) * HTB)
#define PG8_SB(b, h) ((4 + (b) * 2 + (h)) * HTB)
#define PG8_STAGE(bufoff, gbase, voff) do { _Pragma("unroll") for (int _i = 0; _i < 2; ++_i) \
        __builtin_amdgcn_global_load_lds((const unsigned*)((const char*)(gbase) + (voff)[_i]), (PG8_LAS unsigned*)(lds + (bufoff) + ldsw + _i * 8192), 16, 0, 0); } while (0)
#define PG8_LDA(dst, b, h) do { _Pragma("unroll") for (int m = 0; m < 4; ++m) _Pragma("unroll") for (int k = 0; k < 2; ++k) dst[m][k] = *(const PG8_LAS bf16x8*)(lds + PG8_SA(b, h) + aoff + m * 2048 + k * 1024); } while (0)
#define PG8_LDB(dst, b, h) do { _Pragma("unroll") for (int n = 0; n < 2; ++n) _Pragma("unroll") for (int k = 0; k < 2; ++k) dst[n][k] = *(const PG8_LAS bf16x8*)(lds + PG8_SB(b, h) + boff + n * 2048 + k * 1024); } while (0)
#define PG8_MMA(ai, bj, At, Bt) do { __builtin_amdgcn_s_setprio(1); _Pragma("unroll") for (int m = 0; m < 4; ++m) _Pragma("unroll") for (int n = 0; n < 2; ++n) _Pragma("unroll") for (int k = 0; k < 2; ++k) \
        acc[ai][bj][m][n] = __builtin_amdgcn_mfma_f32_16x16x32_bf16(Bt[n][k], At[m][k], acc[ai][bj][m][n], 0, 0, 0); __builtin_amdgcn_s_setprio(0); } while (0)
#define PG8_WAIT_V(n) asm volatile("s_waitcnt vmcnt(" #n ")" ::: "memory")
#define PG8_WAIT_L(n) asm volatile("s_waitcnt lgkmcnt(" #n ")" ::: "memory")
#define PG8_BAR __builtin_amdgcn_s_barrier()
#define PG8_SCHED __builtin_amdgcn_sched_barrier(0)
    Unit cur, nxt; int ui = 0;
    if (!S.next(0, cur)) return;
    f32x4 acc[2][2][4][2];
#pragma unroll
    for (int a = 0; a < 2; ++a)
#pragma unroll
        for (int b = 0; b < 2; ++b)
#pragma unroll
            for (int m = 0; m < 4; ++m)
#pragma unroll
                for (int n = 0; n < 2; ++n) acc[a][b][m][n] = (f32x4){0.f, 0.f, 0.f, 0.f};
    bf16x8 At[4][2], B0[2][2], B1[2][2];
    const char* cA = (const char*)g.A + (size_t)cur.pm * tstepA; const char* cB = (const char*)g.Bt + (size_t)cur.pn * tstepB;
    S.a_ready(cur);
    if constexpr (SP2) {
        PG8_STAGE(PG8_SB(0, 0), cB, voffB); PG8_STAGE(PG8_SB(0, 1), cB + hstepB, voffB); PG8_STAGE(PG8_SA(0, 0), cA, voffA); PG8_STAGE(PG8_SA(0, 1), cA + hstepA, voffA);
        if (wr == 1) PG8_BAR;
        PG8_WAIT_V(2); PG8_BAR;
        PG8_STAGE(PG8_SB(1, 0), cB + kstep, voffB); PG8_STAGE(PG8_SA(1, 0), cA + kstep, voffA); PG8_STAGE(PG8_SB(1, 1), cB + hstepB + kstep, voffB);
        PG8_WAIT_V(6); PG8_BAR;
    } else {
        PG8_STAGE(PG8_SB(0, 0), cB, voffB); PG8_STAGE(PG8_SA(0, 0), cA, voffA); PG8_STAGE(PG8_SB(0, 1), cB + hstepB, voffB); PG8_STAGE(PG8_SA(0, 1), cA + hstepA, voffA);
        if (wr == 1) PG8_BAR;
        PG8_WAIT_V(4); PG8_BAR;
        PG8_STAGE(PG8_SB(1, 0), cB + kstep, voffB); PG8_STAGE(PG8_SA(1, 0), cA + kstep, voffA); PG8_STAGE(PG8_SB(1, 1), cB + hstepB + kstep, voffB);
        PG8_WAIT_V(6); PG8_BAR;
    }
    for (;;) {
        const bool has_next = S.next(ui + 1, nxt);
        const char* nA = has_next ? (const char*)g.A + (size_t)nxt.pm * tstepA : cA; const char* nB = has_next ? (const char*)g.Bt + (size_t)nxt.pn * tstepB : cB;
        for (int t = 0; t < nt; t += 2) {
            const bool last = (t == nt - 2);
            const char* a1 = cA + (size_t)(t + 1) * kstep;
            const char* a2 = last ? nA : cA + (size_t)(t + 2) * kstep; const char* b2 = last ? nB : cB + (size_t)(t + 2) * kstep;
            const char* a3 = a2 + kstep; const char* b3 = b2 + kstep;
            if (last && has_next) S.a_ready(nxt);
            if constexpr (SP2) {
            PG8_LDB(B0, 0, 0); PG8_LDB(B1, 0, 1); PG8_SCHED; PG8_LDA(At, 0, 0); PG8_STAGE(PG8_SA(1, 1), a1 + hstepA, voffA);
            PG8_WAIT_V(8); PG8_WAIT_L(0); PG8_BAR; PG8_MMA(0, 0, At, B0); PG8_MMA(0, 1, At, B1); PG8_BAR; PG8_SCHED;
            PG8_LDA(At, 0, 1); PG8_STAGE(PG8_SB(0, 0), b2, voffB); PG8_STAGE(PG8_SB(0, 1), b2 + hstepB, voffB); PG8_STAGE(PG8_SA(0, 0), a2, voffA);
            PG8_WAIT_V(8); PG8_WAIT_L(0); PG8_BAR; PG8_MMA(1, 0, At, B0); PG8_MMA(1, 1, At, B1); PG8_BAR; PG8_SCHED;
            PG8_LDB(B0, 1, 0); PG8_LDB(B1, 1, 1); PG8_SCHED; PG8_LDA(At, 1, 0); PG8_STAGE(PG8_SA(0, 1), a2 + hstepA, voffA);
            PG8_WAIT_V(8); PG8_WAIT_L(0); PG8_BAR; PG8_MMA(0, 0, At, B0); PG8_MMA(0, 1, At, B1); PG8_BAR; PG8_SCHED;
            PG8_LDA(At, 1, 1); PG8_STAGE(PG8_SB(1, 0), b3, voffB); PG8_STAGE(PG8_SB(1, 1), b3 + hstepB, voffB); PG8_STAGE(PG8_SA(1, 0), a3, voffA);
            PG8_WAIT_V(8); PG8_WAIT_L(0); PG8_BAR; PG8_MMA(1, 0, At, B0); PG8_MMA(1, 1, At, B1); PG8_BAR; PG8_SCHED;
            } else {
            PG8_LDB(B0, 0, 0); PG8_SCHED; PG8_LDA(At, 0, 0); PG8_STAGE(PG8_SA(1, 1), a1 + hstepA, voffA);
            PG8_WAIT_L(8); PG8_BAR; PG8_WAIT_L(0); PG8_MMA(0, 0, At, B0); PG8_BAR; PG8_SCHED;
            PG8_LDB(B1, 0, 1); PG8_STAGE(PG8_SB(0, 0), b2, voffB);
            PG8_BAR; PG8_WAIT_L(0); PG8_MMA(0, 1, At, B1); PG8_BAR;
            PG8_LDA(At, 0, 1); PG8_STAGE(PG8_SA(0, 0), a2, voffA);
            PG8_BAR; PG8_WAIT_L(0); PG8_MMA(1, 0, At, B0); PG8_BAR; PG8_SCHED;
            PG8_STAGE(PG8_SB(0, 1), b2 + hstepB, voffB);
            PG8_WAIT_V(6); PG8_BAR; PG8_MMA(1, 1, At, B1); PG8_BAR;
            PG8_LDB(B0, 1, 0); PG8_SCHED; PG8_LDA(At, 1, 0); PG8_STAGE(PG8_SA(0, 1), a2 + hstepA, voffA);
            PG8_WAIT_L(8); PG8_BAR; PG8_WAIT_L(0); PG8_MMA(0, 0, At, B0); PG8_BAR; PG8_SCHED;
            PG8_LDB(B1, 1, 1); PG8_STAGE(PG8_SB(1, 0), b3, voffB);
            PG8_BAR; PG8_WAIT_L(0); PG8_MMA(0, 1, At, B1); PG8_BAR;
            PG8_LDA(At, 1, 1); PG8_STAGE(PG8_SA(1, 0), a3, voffA);
            PG8_BAR; PG8_WAIT_L(0); PG8_MMA(1, 0, At, B0); PG8_BAR; PG8_SCHED;
            PG8_STAGE(PG8_SB(1, 1), b3 + hstepB, voffB);
            PG8_WAIT_V(6); PG8_BAR; PG8_MMA(1, 1, At, B1); PG8_BAR;
            }
        }
        if constexpr (ALIGN_EPI) { if (wr == 0) PG8_BAR; }
        if constexpr (!Epi::AFTER_DRAIN) { E(acc, cur, wr, wc, fr, fq); S.done(cur); }
        if (!has_next) break;
#pragma unroll
        for (int a = 0; a < 2; ++a)
#pragma unroll
            for (int b = 0; b < 2; ++b)
#pragma unroll
                for (int m = 0; m < 4; ++m)
#pragma unroll
                    for (int n = 0; n < 2; ++n) acc[a][b][m][n] = (f32x4){0.f, 0.f, 0.f, 0.f};
        cur = nxt; cA = nA; cB = nB; ++ui;
        if constexpr (ALIGN_EPI) { if (wr == 1) PG8_BAR; }
    }
    PG8_WAIT_V(0);
    if constexpr (!ALIGN_EPI) { if (wr == 0) PG8_BAR; }
    PG8_BAR;
    if constexpr (Epi::AFTER_DRAIN) { E.fused(acc, cur, wr, wc, fr, fq, lds, wid, lane); S.done(cur); }
#undef PG8_SA
#undef PG8_SB
#undef PG8_STAGE
#undef PG8_LDA
#undef PG8_LDB
#undef PG8_MMA
#undef PG8_WAIT_V
#undef PG8_WAIT_L
#undef PG8_BAR
#undef PG8_SCHED
}
}
#define LAS __attribute__((address_space(3)))
#define XB_TMO      128
#define XB_XCNT(j)  (256  + 64 * (j))
#define XB_XSUB(j)  (1280 + 64 * (j))
#define XB_XGEN(j)  (2304 + 64 * (j))
#define XB_TOP      3328
#define XB_TOPGEN   3392
#define XCD_BAR_WORDS 3456
#define XB_SPIN_CAP (1u << 18)

__device__ __forceinline__ unsigned xb_ld(unsigned* p)              { return __hip_atomic_load(p, __ATOMIC_RELAXED, __HIP_MEMORY_SCOPE_AGENT); }
__device__ __forceinline__ unsigned xb_add(unsigned* p, unsigned v) { return __hip_atomic_fetch_add(p, v, __ATOMIC_RELAXED, __HIP_MEMORY_SCOPE_AGENT); }
__device__ __forceinline__ unsigned xb_xcc_id() { return (unsigned)__builtin_amdgcn_s_getreg((3 << 11) | 20) & 0xFu; }
#define XB_SPIN(cond, bar) do { unsigned _sp = 0; while (cond) { __builtin_amdgcn_s_sleep(1); \
    if ((++_sp & 255u) == 0u) { if (xb_ld(&(bar)[XB_TMO])) break; if (_sp > XB_SPIN_CAP) { atomicAdd(&(bar)[XB_TMO], 1u); break; } } } } while (0)

struct XcdBarrier {
    unsigned* bar; unsigned x;
    volatile LAS unsigned* st;
};

__device__ __forceinline__ XcdBarrier xcd_barrier_post(unsigned* bar, volatile LAS unsigned* st) {
    XcdBarrier b; b.bar = bar; b.x = xb_xcc_id(); b.st = st;
    if (threadIdx.x == 0) (void)xb_add(&bar[XB_XCNT(b.x)], 1u);
    return b;
}
__device__ __forceinline__ void xcd_barrier_complete(unsigned* bar, unsigned x, unsigned& nloc, unsigned& nx) {
    const unsigned G = gridDim.x * gridDim.y * gridDim.z;
    unsigned sum, cnt, mine, sp = 0u;
    for (;;) {
        sum = 0u; cnt = 0u; mine = 0u;
#pragma unroll
        for (unsigned j = 0; j < 16; ++j) { const unsigned c = xb_ld(&bar[XB_XCNT(j)]); sum += c; cnt += (c > 0u) ? 1u : 0u; mine = (j == x) ? c : mine; }
        if (sum == G) break;
        __builtin_amdgcn_s_sleep(1);
        if ((++sp & 255u) == 0u) { if (xb_ld(&bar[XB_TMO])) break; if (sp > XB_SPIN_CAP) { atomicAdd(&bar[XB_TMO], 1u); break; } }
    }
    nloc = mine > 0u ? mine : 1u; nx = cnt > 0u ? cnt : 1u;
}

__device__ __forceinline__ void xcd_barrier(const XcdBarrier& b) {
    asm volatile("s_waitcnt vmcnt(0)" ::: "memory");
    __syncthreads();
    if (threadIdx.x == 0) {
        unsigned* bar = b.bar;
        __builtin_amdgcn_s_waitcnt(0);
        unsigned nloc = b.st[0], nx = b.st[1];
        if (nloc == 0u) { xcd_barrier_complete(bar, b.x, nloc, nx); b.st[0] = nloc; b.st[1] = nx; }
        const unsigned old = xb_add(&bar[XB_XSUB(b.x)], 1u);
        const unsigned gen = old / nloc;
        if (old + 1u == (gen + 1u) * nloc) {
            __builtin_amdgcn_fence(__ATOMIC_RELEASE, "agent");
            asm volatile("s_waitcnt vmcnt(0)" ::: "memory");
            const unsigned og = xb_add(&bar[XB_TOP], 1u);
            const unsigned tg = og / nx;
            if (og + 1u == (tg + 1u) * nx) xb_add(&bar[XB_TOPGEN], 1u);
            else XB_SPIN(xb_ld(&bar[XB_TOPGEN]) == tg, bar);
            __builtin_amdgcn_fence(__ATOMIC_ACQUIRE, "agent");
            xb_add(&bar[XB_XGEN(b.x)], 1u);
            asm volatile("s_waitcnt vmcnt(0)" ::: "memory");
        } else {
            XB_SPIN(xb_ld(&bar[XB_XGEN(b.x)]) == gen, bar);
            __builtin_amdgcn_fence(__ATOMIC_ACQUIRE, "agent");
            asm volatile("s_waitcnt vmcnt(0)" ::: "memory");
        }
    }
    __syncthreads();
}

typedef unsigned short bf16_t;
typedef short bf16x8 __attribute__((ext_vector_type(8)));
typedef short s16x4 __attribute__((ext_vector_type(4)));
typedef float f32x4 __attribute__((ext_vector_type(4)));
typedef float f32x2 __attribute__((ext_vector_type(2)));
typedef float f32x16 __attribute__((ext_vector_type(16)));
typedef unsigned u32x4 __attribute__((ext_vector_type(4)));
typedef unsigned u32x2 __attribute__((ext_vector_type(2)));

constexpr int S = 16384, DM = 1024, FF = 2816, NGU = 2 * FF;
constexpr int PW = 1792;
constexpr int P_CQ = 0, P_CKV = 384, P_KR = 640, P_U = 768, P_V = 1280;
constexpr int QW = 768;
constexpr float EPS = 1e-6f;
constexpr int NTHREADS = 512, NWAVES = 8;
constexpr int LDS_BYTES = 147456;
constexpr int LDS_MISC = 131072;

constexpr size_t MiB = (size_t)1 << 20;
constexpr size_t OFF_SS = 342 * MiB;
constexpr size_t OFF_ROPE = 2 * MiB;
constexpr size_t OFF_WGU = 4 * MiB;
constexpr size_t OFF_WD = 92 * MiB;
constexpr size_t OFF_WIN = 136 * MiB;
constexpr size_t OFF_WUQ = 143 * MiB;
constexpr size_t OFF_WUKV = 145 * MiB;
constexpr size_t OFF_WOUT = 146 * MiB;
constexpr size_t OFF_WCIN = 150 * MiB;
constexpr size_t OFF_WCOUT = 162 * MiB;
constexpr size_t OFF_XB = 166 * MiB;
constexpr size_t OFF_ACT = 198 * MiB;
constexpr size_t OFF_P = OFF_ACT, OFF_Q = OFF_ACT + 56 * MiB, OFF_KN = OFF_ACT + 80 * MiB, OFF_V = OFF_ACT + 96 * MiB, OFF_MIX = OFF_ACT + 112 * MiB;
constexpr size_t OFF_CZ = OFF_ACT, OFF_BG = OFF_ACT + 32 * MiB, OFF_G = OFF_ACT + 64 * MiB;
constexpr size_t OFF_BAR = 361 * MiB;
constexpr size_t WS_END = 362 * MiB;

struct Params {
    const float* in[24];
    float* out;
    unsigned char* ws;
    float inv_freq[16];
    int step_lo, step_hi;
};

__device__ __forceinline__ float bf2f(unsigned short b) { return __uint_as_float((unsigned)b << 16); }
__device__ __forceinline__ unsigned pk_bf16(float lo, float hi) { return pg8::cvt_pk_bf16(lo, hi); }
__device__ __forceinline__ int crow(int r, int h) { return (r & 3) + 8 * (r >> 2) + 4 * h; }
__device__ __forceinline__ float swap32_max(float v) {
    auto rr = __builtin_amdgcn_permlane32_swap(__float_as_uint(v), __float_as_uint(v), false, false);
    return fmaxf(__uint_as_float(rr[0]), __uint_as_float(rr[1]));
}
__device__ __forceinline__ float swap32_sum(float v) {
    auto rr = __builtin_amdgcn_permlane32_swap(__float_as_uint(v), __float_as_uint(v), false, false);
    return __uint_as_float(rr[0]) + __uint_as_float(rr[1]);
}

__device__ __forceinline__ float row_ss(const float* st, int row, int nsl) {
    const f32x4* q = (const f32x4*)(st + (size_t)row * 16);
    const f32x4 a = q[0], b = q[1];
    float s = ((a[0] + a[1]) + (a[2] + a[3])) + ((b[0] + b[1]) + (b[2] + b[3]));
    if (nsl > 8) { const f32x4 c = q[2]; s += (c[0] + c[1]) + (c[2] + c[3]); }
    if (nsl > 12) { const f32x4 d = q[3]; s += (d[0] + d[1]) + (d[2] + d[3]); }
    return s;
}
__device__ __forceinline__ f32x4 row_ss_part(const float* st, int row, int nsl, int fq) {
    return (4 * fq < nsl) ? ((const f32x4*)(st + (size_t)row * 16))[fq] : (f32x4){0.f, 0.f, 0.f, 0.f};
}
__device__ __forceinline__ float row_ss_fin(const f32x4 v) {
    float s = (v[0] + v[1]) + (v[2] + v[3]);
    s += __shfl_xor(s, 16); s += __shfl_xor(s, 32);
    return s;
}

struct EpiPair {
    static constexpr bool PERM = true, AFTER_DRAIN = false;
    bf16_t* O; int ldo; const float* ss; float inv_dim; int mode;
    __device__ __forceinline__ void operator()(const f32x4 (&acc)[2][2][4][2], const pg8::Unit& u, int wr, int wc, int fr, int fq) const {
        const int row0 = u.pm * 256 + wr * 64 + fr, col0 = u.pn * 128 + wc * 32 + 8 * fq;
        f32x4 sp[2][4]; float rsv[2][4];
#pragma unroll
        for (int ai = 0; ai < 2; ++ai)
#pragma unroll
            for (int m = 0; m < 4; ++m) sp[ai][m] = row_ss_part(ss, row0 + ai * 128 + m * 16, 16, fq);
#pragma unroll
        for (int ai = 0; ai < 2; ++ai)
#pragma unroll
            for (int m = 0; m < 4; ++m) rsv[ai][m] = rsqrtf(row_ss_fin(sp[ai][m]) * inv_dim + EPS);
        if (mode == 0) {
#pragma unroll
            for (int ai = 0; ai < 2; ++ai)
#pragma unroll
                for (int m = 0; m < 4; ++m) {
                    const int row = row0 + ai * 128 + m * 16;
                    const float rs = rsv[ai][m], c1 = rs * -1.4426950408889634f, rs2 = rs * rs;
                    f32x2 h[4];
#pragma unroll
                    for (int n = 0; n < 2; ++n)
#pragma unroll
                        for (int q = 0; q < 2; ++q) {
                            const f32x2 A = {acc[ai][0][m][n][2 * q], acc[ai][0][m][n][2 * q + 1]}, B = {acc[ai][1][m][n][2 * q], acc[ai][1][m][n][2 * q + 1]};
                            const f32x2 ab = A * B, ea = A * c1;
                            f32x2 d; d.x = __builtin_amdgcn_exp2f(ea.x); d.y = __builtin_amdgcn_exp2f(ea.y);
                            d = d + 1.0f;
                            f32x2 r; r.x = __builtin_amdgcn_rcpf(d.x); r.y = __builtin_amdgcn_rcpf(d.y);
                            h[n * 2 + q] = ab * (r * rs2);
                        }
                    u32x4 w; w.x = pk_bf16(h[0].x, h[0].y); w.y = pk_bf16(h[1].x, h[1].y); w.z = pk_bf16(h[2].x, h[2].y); w.w = pk_bf16(h[3].x, h[3].y);
                    *(u32x4*)(O + (size_t)row * ldo + col0) = w;
                }
        } else {
#pragma unroll
            for (int ai = 0; ai < 2; ++ai)
#pragma unroll
                for (int m = 0; m < 4; ++m) {
                    const int row = row0 + ai * 128 + m * 16;
                    const float rs2 = rsv[ai][m] * rsv[ai][m];
                    f32x2 h[4];
#pragma unroll
                    for (int n = 0; n < 2; ++n)
#pragma unroll
                        for (int q = 0; q < 2; ++q) {
                            const f32x2 A = {acc[ai][0][m][n][2 * q], acc[ai][0][m][n][2 * q + 1]}, B = {acc[ai][1][m][n][2 * q], acc[ai][1][m][n][2 * q + 1]};
                            h[n * 2 + q] = (A * B) * rs2;
                        }
                    u32x4 w; w.x = pk_bf16(h[0].x, h[0].y); w.y = pk_bf16(h[1].x, h[1].y); w.z = pk_bf16(h[2].x, h[2].y); w.w = pk_bf16(h[3].x, h[3].y);
                    *(u32x4*)(O + (size_t)row * ldo + col0) = w;
                }
        }
    }
};

struct EpiRes {
    static constexpr bool PERM = true, AFTER_DRAIN = false;
    bf16_t* XB; float* ss_out; float alpha;
    __device__ __forceinline__ void operator()(const f32x4 (&acc)[2][2][4][2], const pg8::Unit& u, int wr, int wc, int fr, int fq) const {
        const int row0 = u.pm * 256 + wr * 64 + fr, col0 = u.pn * 256 + wc * 32 + 8 * fq;
#pragma unroll
        for (int ai = 0; ai < 2; ++ai)
#pragma unroll
            for (int m = 0; m < 4; ++m) {
                const int row = row0 + ai * 128 + m * 16;
                float sq = 0.f;
#pragma unroll
                for (int bj = 0; bj < 2; ++bj) {
                    bf16_t* px = XB + (size_t)row * DM + col0 + bj * 128;
                    const u32x4 xo = *(const u32x4*)px;
                    u32x4 w;
#pragma unroll
                    for (int i = 0; i < 4; ++i) {
                        const float lo = __uint_as_float(xo[i] << 16) + acc[ai][bj][m][i >> 1][(i & 1) * 2] * alpha;
                        const float hi = __uint_as_float(xo[i] & 0xffff0000u) + acc[ai][bj][m][i >> 1][(i & 1) * 2 + 1] * alpha;
                        const unsigned pk = pk_bf16(lo, hi);
                        w[i] = pk;
                        const float rl = __uint_as_float(pk << 16), rh = __uint_as_float(pk & 0xffff0000u);
                        sq += rl * rl + rh * rh;
                    }
                    *(u32x4*)px = w;
                }
                sq += __shfl_xor(sq, 16); sq += __shfl_xor(sq, 32);
                if (fq == 0) ss_out[(size_t)row * 16 + u.pn * 4 + wc] = sq;
                asm volatile("" ::: "memory");
            }
    }
};

struct EpiRow {
    static constexpr bool PERM = true, AFTER_DRAIN = false;
    bf16_t* O; int ldo; int split_tiles; size_t split_stride;
    const float* ss; float inv_dim; int nsl;
    int gelu_from; int rope_pn, rope_bj, rope_wc;
    const float* cs; const float* sn;
    unsigned long long stat_map; float* stb;
    __device__ __forceinline__ void operator()(const f32x4 (&acc)[2][2][4][2], const pg8::Unit& u, int wr, int wc, int fr, int fq) const {
        const int row0 = u.pm * 256 + wr * 64 + fr;
        int colt = u.pn * 256; bf16_t* base = O;
        if (split_tiles && u.pn >= split_tiles) { base += split_stride; colt -= split_tiles * 256; }
        const bool do_gelu = u.pn >= gelu_from;
        f32x4 sp[2][4]; float rsv[2][4];
#pragma unroll
        for (int ai = 0; ai < 2; ++ai)
#pragma unroll
            for (int m = 0; m < 4; ++m) sp[ai][m] = row_ss_part(ss, row0 + ai * 128 + m * 16, nsl, fq);
#pragma unroll
        for (int ai = 0; ai < 2; ++ai)
#pragma unroll
            for (int m = 0; m < 4; ++m) rsv[ai][m] = rsqrtf(row_ss_fin(sp[ai][m]) * inv_dim + EPS);
#pragma unroll
        for (int bj = 0; bj < 2; ++bj) {
            const bool do_rope = (u.pn == rope_pn) && (rope_bj < 0 || (bj == rope_bj && wc == rope_wc));
            const int sidx = (int)((stat_map >> (4 * (u.pn * 2 + bj))) & 15ull);
            float* st = stb + (size_t)(sidx > 0 ? sidx - 1 : 0) * ((size_t)S * 16);
            const int sbase = (int)((0x0a0300u >> (8 * (sidx > 0 ? sidx - 1 : 0))) & 255u);
            const int col0 = colt + bj * 128 + wc * 32 + 8 * fq;
#pragma unroll
            for (int ai = 0; ai < 2; ++ai)
#pragma unroll
                for (int m = 0; m < 4; ++m) {
                    const int row = row0 + ai * 128 + m * 16;
                    const float rs = rsv[ai][m];
                    float v[8];
#pragma unroll
                    for (int n = 0; n < 2; ++n)
#pragma unroll
                        for (int j = 0; j < 4; ++j) v[n * 4 + j] = acc[ai][bj][m][n][j] * rs;
                    if (do_gelu) {
#pragma unroll
                        for (int i = 0; i < 8; i += 2) { const f32x2 g = pg8::gelu_pk((f32x2){v[i], v[i + 1]}); v[i] = g.x; v[i + 1] = g.y; }
                    }
                    if (do_rope) {
                        const f32x4 c0 = *(const f32x4*)(cs + (size_t)row * 16 + 8 * (fq & 1)), c1 = *(const f32x4*)(cs + (size_t)row * 16 + 8 * (fq & 1) + 4);
                        const f32x4 s0 = *(const f32x4*)(sn + (size_t)row * 16 + 8 * (fq & 1)), s1 = *(const f32x4*)(sn + (size_t)row * 16 + 8 * (fq & 1) + 4);
                        const float sg = (fq < 2) ? -1.f : 1.f;
#pragma unroll
                        for (int i = 0; i < 8; ++i) {
                            const float pt = __shfl_xor(v[i], 32);
                            const float cc = i < 4 ? c0[i & 3] : c1[i & 3], sv = i < 4 ? s0[i & 3] : s1[i & 3];
                            v[i] = v[i] * cc + sg * pt * sv;
                        }
                    }
                    if (sidx) {
                        float sq = 0.f;
#pragma unroll
                        for (int i = 0; i < 8; ++i) sq += v[i] * v[i];
                        sq += __shfl_xor(sq, 16); sq += __shfl_xor(sq, 32);
                        if (fq == 0) st[(size_t)row * 16 + (u.pn * 2 + bj - sbase) * 4 + wc] = sq;
                    }
                    u32x4 w; w.x = pk_bf16(v[0], v[1]); w.y = pk_bf16(v[2], v[3]); w.z = pk_bf16(v[4], v[5]); w.w = pk_bf16(v[6], v[7]);
                    *(u32x4*)(base + (size_t)row * ldo + col0) = w;
                }
        }
    }
};

struct Job { const float* W; int K, N; bf16_t* dst; const float* gain; int mode; float scale; };
enum { M_PLAIN = 0, M_GATE, M_UP, M_EVENIN, M_Q, M_KV, M_CONVIN };
constexpr float Q_SCALE = 0.10206207261596577f * 1.4426950408889634f;

__device__ __forceinline__ int job_items(int j) {
    if (j < 24) { const int t = j % 6; return (t == 2 || t == 5) ? 44 * 32 : 16 * 88; }
    if (j < 32) { const int t = (j - 24) & 3; return t == 0 ? 16 * 53 : (t == 1 ? 6 * 24 : (t == 2 ? 4 * 32 : 16 * 32)); }
    return ((j - 32) & 1) ? 16 * 32 : 16 * 96;
}
__device__ __forceinline__ Job get_job(const Params& p, int j) {
    Job b; b.scale = 1.f; b.gain = nullptr; b.mode = M_PLAIN;
    unsigned char* ws = p.ws;
    if (j < 24) {
        const int l = j / 6, t = j % 6, post = t >= 3, tt = t % 3;
        const float* nrm = p.in[post ? 7 : 2] + l * DM;
        const float* wg = p.in[post ? 8 : 3] + (size_t)l * DM * FF;
        const float* wu = p.in[post ? 9 : 4] + (size_t)l * DM * FF;
        const float* wd = p.in[post ? 10 : 5] + (size_t)l * DM * FF;
        if (tt == 0) { b.W = wg; b.K = DM; b.N = FF; b.dst = (bf16_t*)(ws + OFF_WGU) + (size_t)(2 * l + post) * NGU * DM; b.gain = nrm; b.mode = M_GATE; }
        else if (tt == 1) { b.W = wu; b.K = DM; b.N = FF; b.dst = (bf16_t*)(ws + OFF_WGU) + (size_t)(2 * l + post) * NGU * DM; b.gain = nrm; b.mode = M_UP; }
        else { b.W = wd; b.K = FF; b.N = DM; b.dst = (bf16_t*)(ws + OFF_WD) + (size_t)(2 * l + post) * DM * FF; }
    } else if (j < 32) {
        const int e = (j - 24) >> 2, t = (j - 24) & 3;
        if (t == 0) { b.W = p.in[11] + (size_t)e * DM * 1696; b.K = DM; b.N = 1696; b.dst = (bf16_t*)(ws + OFF_WIN) + (size_t)e * PW * DM; b.gain = p.in[6] + (2 * e) * DM; b.mode = M_EVENIN; }
        else if (t == 1) { b.W = p.in[13] + (size_t)e * 384 * 768; b.K = 384; b.N = 768; b.dst = (bf16_t*)(ws + OFF_WUQ) + (size_t)e * 768 * 384; b.gain = p.in[12] + e * 384; b.mode = M_Q; b.scale = Q_SCALE; }
        else if (t == 2) { b.W = p.in[15] + (size_t)e * 256 * 1024; b.K = 256; b.N = 1024; b.dst = (bf16_t*)(ws + OFF_WUKV) + (size_t)e * 1024 * 256; b.gain = p.in[14] + e * 256; b.mode = M_KV; }
        else { b.W = p.in[19] + (size_t)e * DM * DM; b.K = DM; b.N = DM; b.dst = (bf16_t*)(ws + OFF_WOUT) + (size_t)e * DM * DM; }
    } else {
        const int o = (j - 32) >> 1, t = (j - 32) & 1;
        if (t == 0) { b.W = p.in[20] + (size_t)o * DM * 3072; b.K = DM; b.N = 3072; b.dst = (bf16_t*)(ws + OFF_WCIN) + (size_t)o * 3072 * DM; b.gain = p.in[6] + (2 * o + 1) * DM; b.mode = M_CONVIN; }
        else { b.W = p.in[22] + (size_t)o * DM * DM; b.K = DM; b.N = DM; b.dst = (bf16_t*)(ws + OFF_WCOUT) + (size_t)o * DM * DM; }
    }
    return b;
}
__device__ __forceinline__ int map_row(int mode, int n) {
    switch (mode) {
        case M_GATE: return 256 * (n >> 7) + (n & 127);
        case M_UP: return 256 * (n >> 7) + 128 + (n & 127);
        case M_EVENIN: return n < 672 ? n : n + 96;
        case M_Q: { const int hd = n / 96, d = n - hd * 96; return d < 64 ? hd * 64 + d : 512 + hd * 32 + (d - 64); }
        case M_KV: { const int hd = n >> 7, d = n & 127; return d < 64 ? hd * 64 + d : 512 + hd * 64 + (d - 64); }
        case M_CONVIN: { if (n < 1024) return 2048 + n; if (n < 2048) { const int jn = n - 1024; return 256 * (jn >> 7) + (jn & 127); } const int jn = n - 2048; return 256 * (jn >> 7) + 128 + (jn & 127); }
        default: return n;
    }
}
__device__ __forceinline__ void transpose_item(const Job& jb, LAS float* scr, int item, int lane) {
    const int nblk = jb.N / 32, kb = item / nblk, nb = item - kb * nblk, k0 = 64 * kb, n0 = 32 * nb;
    const int kr = lane >> 3, c4 = (lane & 7) * 4;
    f32x4 v[8]; float gk[8];
#pragma unroll
    for (int i = 0; i < 8; ++i) {
        const int kk = 8 * i + kr;
        v[i] = *(const f32x4*)(jb.W + (size_t)(k0 + kk) * jb.N + n0 + c4);
        gk[i] = (jb.gain ? jb.gain[k0 + kk] : 1.0f) * jb.scale;
    }
#pragma unroll
    for (int i = 0; i < 8; ++i) {
        const int kk = 8 * i + kr;
        LAS float* d = scr + kk * 33 + c4;
        d[0] = v[i][0] * gk[i]; d[1] = v[i][1] * gk[i]; d[2] = v[i][2] * gk[i]; d[3] = v[i][3] * gk[i];
    }
    asm volatile("s_waitcnt lgkmcnt(0)" ::: "memory");
    const int c = lane & 7, r0 = map_row(jb.mode, n0);
#pragma unroll
    for (int j = 0; j < 4; ++j) {
        const int n = (lane >> 3) + 8 * j; const LAS float* s = scr + (8 * c) * 33 + n;
        u32x4 o; o.x = pk_bf16(s[0 * 33], s[1 * 33]); o.y = pk_bf16(s[2 * 33], s[3 * 33]); o.z = pk_bf16(s[4 * 33], s[5 * 33]); o.w = pk_bf16(s[6 * 33], s[7 * 33]);
        *(u32x4*)(jb.dst + (size_t)(r0 + n) * jb.K + k0 + 8 * c) = o;
    }
    asm volatile("s_waitcnt lgkmcnt(0)" ::: "memory");
}

__device__ __forceinline__ void convert_jobs(const Params& p, LAS unsigned char* lds, int j_lo, int j_hi, int w, int nw, int lane, int wave) {
    LAS float* scr = (LAS float*)(lds + wave * 8704);
    int total = 0;
    for (int j = j_lo; j < j_hi; ++j) total += job_items(j);
    for (int it = w; it < total; it += nw) {
        int r = it, j = j_lo;
        for (; j < j_hi; ++j) { const int c = job_items(j); if (r < c) break; r -= c; }
        const Job jb = get_job(p, j);
        transpose_item(jb, scr, r, lane);
    }
}
__device__ __forceinline__ void prologue(const Params& p, LAS unsigned char* lds, int gw, int ngw, int lane, int wave) {
    unsigned char* ws = p.ws;
    {
        float* cs = (float*)(ws + OFF_ROPE); float* sn = cs + S * 16;
        const int* pos = (const int*)p.in[1];
        for (int idx = gw * 64 + lane; idx < S * 16; idx += ngw * 64) {
            const int t = idx >> 4, i = idx & 15;
            const float ang = (float)pos[t] * p.inv_freq[i];
            const double a = (double)ang;
            const double k = rint(a * 0.15915494309189535);
            const double r = a - k * 6.283185307179586;
            const double r2 = r * r;
            double ts = r, ssum = r, tc = 1.0, csum = 1.0;
#pragma unroll 1
            for (int q = 1; q <= 15; ++q) {
                tc *= -r2 / (double)((2 * q - 1) * (2 * q)); csum += tc;
                ts *= -r2 / (double)((2 * q) * (2 * q + 1)); ssum += ts;
            }
            cs[idx] = (float)csum; sn[idx] = (float)ssum;
        }
    }
    {
        const float* x = p.in[0]; bf16_t* XB = (bf16_t*)(ws + OFF_XB); float* ss0 = (float*)(ws + OFF_SS);
        for (int row = gw; row < S; row += ngw) {
            const f32x4* xr = (const f32x4*)(x + (size_t)row * DM) + lane;
            float s = 0.f;
#pragma unroll
            for (int j = 0; j < 4; ++j) {
                const f32x4 v = xr[64 * j];
                u32x2 w; w.x = pk_bf16(v[0], v[1]); w.y = pk_bf16(v[2], v[3]);
                ((u32x2*)(XB + (size_t)row * DM) + lane)[64 * j] = w;
                const float a = __uint_as_float(w.x << 16), b = __uint_as_float(w.x & 0xffff0000u), c = __uint_as_float(w.y << 16), d = __uint_as_float(w.y & 0xffff0000u);
                s += (a * a + b * b) + (c * c + d * d);
            }
#pragma unroll
            for (int o = 1; o < 64; o <<= 1) s += __shfl_xor(s, o);
            if (lane < 16) ss0[(size_t)row * 16 + lane] = (lane == 0) ? s : 0.f;
        }
    }
    for (int e = 0; e < 2; ++e) {
        u32x4* z = (u32x4*)((bf16_t*)(ws + OFF_WIN) + (size_t)e * PW * DM + (size_t)672 * DM);
        for (int idx = gw * 64 + lane; idx < 96 * DM / 8; idx += ngw * 64) z[idx] = (u32x4){0u, 0u, 0u, 0u};
    }
    convert_jobs(p, lds, 0, 3, gw, ngw, lane, wave);
}

__device__ __forceinline__ void sgu_unit(LAS unsigned char* lds, int unit, const bf16_t* __restrict__ P, const float* __restrict__ ssv,
                                         const float* __restrict__ sgw, const float* __restrict__ sgb, const float* __restrict__ sgn, bf16_t* __restrict__ MIX) {
    int tid_l = threadIdx.x; asm volatile("" : "+v"(tid_l)); const int tid = tid_l, lane = tid & 63, wid = __builtin_amdgcn_readfirstlane(tid >> 6), r32 = lane & 31, hi = lane >> 5;
    const int chunk = unit >> 1, hf = unit & 1, s0 = chunk * 128;
    LAS float* rv = (LAS float*)lds;
    LAS unsigned short* vT = (LAS unsigned short*)(lds + 1024);
    if (tid < 128) rv[tid] = rsqrtf(row_ss(ssv, s0 + tid, 16) * (1.0f / 512.0f) + EPS);
#pragma unroll
    for (int i = 0; i < 8; ++i) {
        const int c = tid + 512 * i, srow = c >> 5, part = c & 31;
        const u32x4 d = *(const u32x4*)(P + (size_t)(s0 + srow) * PW + P_V + hf * 256 + part * 8);
        LAS unsigned short* dst = vT + (size_t)(part * 8) * 136 + srow;
        dst[0 * 136] = (unsigned short)(d.x & 0xffffu); dst[1 * 136] = (unsigned short)(d.x >> 16);
        dst[2 * 136] = (unsigned short)(d.y & 0xffffu); dst[3 * 136] = (unsigned short)(d.y >> 16);
        dst[4 * 136] = (unsigned short)(d.z & 0xffffu); dst[5 * 136] = (unsigned short)(d.z >> 16);
        dst[6 * 136] = (unsigned short)(d.w & 0xffffu); dst[7 * 136] = (unsigned short)(d.w >> 16);
    }
    __syncthreads();
    const int gl = wid & 3, rh = wid >> 2, g = 4 * hf + gl;
    f32x16 acc[2][2];
#pragma unroll
    for (int a = 0; a < 2; ++a)
#pragma unroll
        for (int b = 0; b < 2; ++b)
#pragma unroll
            for (int r = 0; r < 16; ++r) acc[a][b][r] = 0.f;
#pragma unroll
    for (int mt = 0; mt < 2; ++mt) {
        const int T0 = 64 * rh + 32 * mt, nks = (T0 + 32) >> 4, t = T0 + r32;
        for (int ks = 0; ks < nks; ++ks) {
            const int sb = 16 * ks + 8 * hi;
            const float* wp = sgw + ((size_t)g * 128 + t) * 128 + sb;
            const f32x4 w0 = *(const f32x4*)wp, w1 = *(const f32x4*)(wp + 4);
            const f32x4 q0 = *(const LAS f32x4*)(rv + sb), q1 = *(const LAS f32x4*)(rv + sb + 4);
            float a[8];
#pragma unroll
            for (int j = 0; j < 4; ++j) { a[j] = (sb + j <= t) ? w0[j] * q0[j] : 0.f; a[4 + j] = (sb + 4 + j <= t) ? w1[j] * q1[j] : 0.f; }
            u32x4 aw; aw.x = pk_bf16(a[0], a[1]); aw.y = pk_bf16(a[2], a[3]); aw.z = pk_bf16(a[4], a[5]); aw.w = pk_bf16(a[6], a[7]);
            const bf16x8 af = __builtin_bit_cast(bf16x8, aw);
#pragma unroll
            for (int nt = 0; nt < 2; ++nt) {
                const bf16x8 bfr = *(const LAS bf16x8*)(vT + (size_t)(gl * 64 + 32 * nt + r32) * 136 + sb);
                acc[mt][nt] = __builtin_amdgcn_mfma_f32_32x32x16_bf16(bfr, af, acc[mt][nt], 0, 0, 0);
            }
        }
    }
#pragma unroll
    for (int mt = 0; mt < 2; ++mt) {
        const int tt = 64 * rh + 32 * mt + r32;
        const float bias = sgb[g * 128 + tt];
#pragma unroll
        for (int nt = 0; nt < 2; ++nt)
#pragma unroll
            for (int rg = 0; rg < 4; ++rg) {
                const int col = g * 64 + 32 * nt + 8 * rg + 4 * hi;
                const f32x4 gn = *(const f32x4*)(sgn + col);
                const u32x2 uu = *(const u32x2*)(P + (size_t)(s0 + tt) * PW + P_U + col);
                const float o0 = __uint_as_float(uu.x << 16) * (gn[0] * acc[mt][nt][4 * rg + 0] + bias);
                const float o1 = __uint_as_float(uu.x & 0xffff0000u) * (gn[1] * acc[mt][nt][4 * rg + 1] + bias);
                const float o2 = __uint_as_float(uu.y << 16) * (gn[2] * acc[mt][nt][4 * rg + 2] + bias);
                const float o3 = __uint_as_float(uu.y & 0xffff0000u) * (gn[3] * acc[mt][nt][4 * rg + 3] + bias);
                u32x2 w; w.x = pk_bf16(o0, o1); w.y = pk_bf16(o2, o3);
                *(u32x2*)(MIX + (size_t)(s0 + tt) * DM + 512 + col) = w;
            }
    }
    __syncthreads();
}

constexpr int AT_KSTR = 208, AT_VSTR = 192, AT_KB = 64 * AT_KSTR, AT_VB = 64 * AT_VSTR;
constexpr float ATT_THR = 8.0f;
#define MX3(a, b, c) __builtin_fmaxf(__builtin_fmaxf((a), (b)), (c))
typedef __bf16 bf16x2_t __attribute__((ext_vector_type(2)));
__device__ __forceinline__ unsigned pk2(float lo, float hi) { f32x2 v = {lo, hi}; bf16x2_t b = __builtin_convertvector(v, bf16x2_t); return __builtin_bit_cast(unsigned, b); }
__device__ __forceinline__ float rowmax32(const f32x16& a, const f32x16& b) {
    float x = MX3(a[0], a[1], b[0]), y = MX3(a[2], a[3], b[1]); x = MX3(x, b[2], b[3]);
#pragma unroll
    for (int r = 4; r < 16; r += 4) { x = MX3(x, a[r], a[r + 1]); y = MX3(y, a[r + 2], a[r + 3]); x = MX3(x, b[r], b[r + 1]); y = MX3(y, b[r + 2], b[r + 3]); }
    return swap32_max(__builtin_fmaxf(x, y));
}
__device__ __forceinline__ void attn_kload(bf16x8 (&kf)[12], const LAS unsigned char* Ks, int r32, int hi) {
#pragma unroll
    for (int d0 = 0; d0 < 6; ++d0) {
        kf[2 * d0] = *(const LAS bf16x8*)(Ks + r32 * AT_KSTR + d0 * 32 + hi * 16);
        kf[2 * d0 + 1] = *(const LAS bf16x8*)(Ks + (32 + r32) * AT_KSTR + d0 * 32 + hi * 16);
    }
}
__device__ __forceinline__ void attn_qk(f32x16& s0, f32x16& s1, const bf16x8 (&kf)[12], const bf16x8 (&qf)[6], const f32x16& negm) {
#pragma unroll
    for (int d0 = 0; d0 < 6; ++d0) {
        if (d0 == 0) { s0 = __builtin_amdgcn_mfma_f32_32x32x16_bf16(kf[0], qf[0], negm, 0, 0, 0); s1 = __builtin_amdgcn_mfma_f32_32x32x16_bf16(kf[1], qf[0], negm, 0, 0, 0); }
        else { s0 = __builtin_amdgcn_mfma_f32_32x32x16_bf16(kf[2 * d0], qf[d0], s0, 0, 0, 0); s1 = __builtin_amdgcn_mfma_f32_32x32x16_bf16(kf[2 * d0 + 1], qf[d0], s1, 0, 0, 0); }
    }
}
__device__ __forceinline__ void attn_mask(f32x16& s0, f32x16& s1, int jb, int qrel, int hi) {
#pragma unroll
    for (int r = 0; r < 16; ++r) {
        const int kv = 64 * jb + crow(r, hi);
        if (kv > qrel) s0[r] = -INFINITY;
        if (kv + 32 > qrel) s1[r] = -INFINITY;
    }
}
__device__ __forceinline__ void attn_unit(LAS unsigned char* lds, const bf16_t* __restrict__ Qb, const bf16_t* __restrict__ KN, const bf16_t* __restrict__ Pb,
                                          const bf16_t* __restrict__ Vb, bf16_t* __restrict__ MIX, int h, int qb) {
    int tid_l = threadIdx.x; asm volatile("" : "+v"(tid_l)); const int tid = tid_l, lane = tid & 63, wid = __builtin_amdgcn_readfirstlane(tid >> 6), r32 = lane & 31, hi = lane >> 5;
    const int qrow = qb * 256 + wid * 32 + r32, qrel = 32 * wid + r32;
    bf16x8 qf[6];
    {
        const bf16_t* qp = Qb + (size_t)qrow * QW;
#pragma unroll
        for (int d0 = 0; d0 < 4; ++d0) qf[d0] = *(const bf16x8*)(qp + h * 64 + d0 * 16 + hi * 8);
#pragma unroll
        for (int d0 = 4; d0 < 6; ++d0) qf[d0] = *(const bf16x8*)(qp + 512 + h * 32 + (d0 - 4) * 16 + hi * 8);
    }
    const int NT = 4 * qb + 4;
    const int ra = tid / 12, pa = tid - ra * 12;
    const int cb = 512 + tid, rb = cb / 12, pb = cb - rb * 12;
    const bf16_t* srcA = pa < 8 ? KN + (size_t)ra * 512 + h * 64 + pa * 8 : Pb + (size_t)ra * PW + P_KR + (pa - 8) * 8;
    const size_t strA = pa < 8 ? (size_t)64 * 512 : (size_t)64 * PW;
    const bf16_t* srcB = pb < 8 ? KN + (size_t)rb * 512 + h * 64 + pb * 8 : Pb + (size_t)rb * PW + P_KR + (pb - 8) * 8;
    const size_t strB = pb < 8 ? (size_t)64 * 512 : (size_t)64 * PW;
    const bf16_t* srcV = Vb + (size_t)(tid >> 3) * 512 + h * 64 + (tid & 7) * 8;
    const int dstA = ra * AT_KSTR + pa * 16, dstB = rb * AT_KSTR + pb * 16, dstV = 3 * AT_KB + (tid >> 3) * AT_VSTR + (tid & 7) * 16;
    const bool hasB = tid < 256;
    u32x4 ga, gb = (u32x4){0u, 0u, 0u, 0u}, gv;
    ga = *(const u32x4*)srcA; gv = *(const u32x4*)srcV; if (hasB) gb = *(const u32x4*)srcB;
    *(LAS u32x4*)(lds + dstA) = ga; *(LAS u32x4*)(lds + dstV) = gv; if (hasB) *(LAS u32x4*)(lds + dstB) = gb;
    ga = *(const u32x4*)(srcA + strA); if (hasB) gb = *(const u32x4*)(srcB + strB);
    *(LAS u32x4*)(lds + AT_KB + dstA) = ga; if (hasB) *(LAS u32x4*)(lds + AT_KB + dstB) = gb;
    __syncthreads();
    float mref = 0.f, lrun = 0.f, mxc;
    f32x16 o0, o1, negm, sA0, sA1, sB0, sB1;
#pragma unroll
    for (int r = 0; r < 16; ++r) { o0[r] = 0.f; o1[r] = 0.f; negm[r] = 0.f; }
    const int i16 = lane & 15, vq = i16 >> 2, vp = i16 & 3, vblk = (lane >> 4) & 1;
    const int voff = 3 * AT_KB + (4 * hi + vq) * AT_VSTR + vblk * 32 + vp * 8;
    const bool lead = wid < 4;
    const int wofs = lead ? 1 : 0;
    if (lead) {
        ga = *(const u32x4*)(srcA + 2 * strA); if (hasB) gb = *(const u32x4*)(srcB + 2 * strB); gv = *(const u32x4*)(srcV + (size_t)64 * 512);
        *(LAS u32x4*)(lds + 2 * AT_KB + dstA) = ga; if (hasB) *(LAS u32x4*)(lds + 2 * AT_KB + dstB) = gb; *(LAS u32x4*)(lds + AT_VB + dstV) = gv;
    }
    { bf16x8 kf0[12]; attn_kload(kf0, lds, r32, hi); attn_qk(sA0, sA1, kf0, qf, negm); }
    if (qb == 0) attn_mask(sA0, sA1, 0, qrel, hi);
    mref = rowmax32(sA0, sA1);
#pragma unroll
    for (int r = 0; r < 16; ++r) { sA0[r] -= mref; sA1[r] -= mref; negm[r] = -mref; }
    mxc = 0.f;
    bf16x8 pf[4];
    int m3 = 0;
#define ATT_M3(x) (((x) >= 3) ? (x) - 3 : (x))
#define ATT_BAR() do { asm volatile("s_waitcnt lgkmcnt(0)" ::: "memory"); __builtin_amdgcn_s_barrier(); asm volatile("" ::: "memory"); } while (0)
#define ATT_PART_B(N0, N1, VS) do { \
        const LAS unsigned char* Vs = lds + voff + (VS) * AT_VB; \
        s16x4 vlo[8], vhi[8]; \
        _Pragma("unroll") for (int ks = 0; ks < 4; ++ks) { \
            _Pragma("unroll") for (int db = 0; db < 2; ++db) { \
                const LAS unsigned char* vp0 = Vs + ks * 16 * AT_VSTR + db * 64; \
                vlo[ks * 2 + db] = __builtin_bit_cast(s16x4, __builtin_amdgcn_ds_read_tr16_b64_v4i16((LAS s16x4*)vp0)); \
                vhi[ks * 2 + db] = __builtin_bit_cast(s16x4, __builtin_amdgcn_ds_read_tr16_b64_v4i16((LAS s16x4*)(vp0 + 8 * AT_VSTR))); } } \
        __builtin_amdgcn_sched_barrier(0); \
        _Pragma("unroll") for (int ks = 0; ks < 4; ++ks) { \
            _Pragma("unroll") for (int db = 0; db < 2; ++db) { \
                const s16x4 lo = vlo[ks * 2 + db], hh = vhi[ks * 2 + db]; \
                const bf16x8 vf = (bf16x8){lo[0], lo[1], lo[2], lo[3], hh[0], hh[1], hh[2], hh[3]}; \
                if (db == 0) o0 = __builtin_amdgcn_mfma_f32_32x32x16_bf16(vf, pf[ks], o0, 0, 0, 0); \
                else o1 = __builtin_amdgcn_mfma_f32_32x32x16_bf16(vf, pf[ks], o1, 0, 0, 0); } } \
        mxc = rowmax32(N0, N1); \
        _Pragma("unroll") for (int i_ = 0; i_ < 8; ++i_) { __builtin_amdgcn_sched_group_barrier(0x008, 1, 1); __builtin_amdgcn_sched_group_barrier(0x002, 3, 1); } \
        __builtin_amdgcn_sched_barrier(0); \
    } while (0)
#define ATT_STEP(C0, C1, N0, N1, T) do { \
        const int t_ = (T), w_ = t_ + wofs; \
        if (w_ + 2 < NT) { ga = *(const u32x4*)(srcA + (size_t)(w_ + 2) * strA); if (hasB) gb = *(const u32x4*)(srcB + (size_t)(w_ + 2) * strB); } \
        if (w_ + 1 < NT) gv = *(const u32x4*)(srcV + (size_t)(w_ + 1) * 64 * 512); \
        if (t_ > 0) ATT_PART_B(C0, C1, ATT_M3(m3 + 2)); \
        if (lead) ATT_BAR(); \
        if (__any(mxc > ATT_THR)) { \
            const float dl = fmaxf(mxc, 0.f); mref += dl; const float al = __builtin_amdgcn_exp2f(-dl); lrun *= al; \
            _Pragma("unroll") for (int r = 0; r < 16; ++r) { C0[r] -= dl; C1[r] -= dl; negm[r] = -mref; o0[r] *= al; o1[r] *= al; } \
        } \
        const LAS unsigned char* Kn = lds + ATT_M3(m3 + 1) * AT_KB; \
        bf16x8 kf[12]; attn_kload(kf, Kn, r32, hi); \
        __builtin_amdgcn_sched_barrier(0); \
        attn_qk(N0, N1, kf, qf, negm); \
        float ps0 = 0.f, ps1 = 0.f, ps2 = 0.f, ps3 = 0.f; \
        _Pragma("unroll") for (int r = 0; r < 16; r += 2) { C0[r] = __builtin_amdgcn_exp2f(C0[r]); C1[r] = __builtin_amdgcn_exp2f(C1[r]); C0[r + 1] = __builtin_amdgcn_exp2f(C0[r + 1]); C1[r + 1] = __builtin_amdgcn_exp2f(C1[r + 1]); \
            ps0 += C0[r]; ps1 += C1[r]; ps2 += C0[r + 1]; ps3 += C1[r + 1]; } \
        lrun += (ps0 + ps1) + (ps2 + ps3); \
        _Pragma("unroll") for (int ks = 0; ks < 2; ++ks) { \
            u32x4 w0, w1; \
            w0.x = pk2(C0[8 * ks + 0], C0[8 * ks + 1]); w0.y = pk2(C0[8 * ks + 2], C0[8 * ks + 3]); w0.z = pk2(C0[8 * ks + 4], C0[8 * ks + 5]); w0.w = pk2(C0[8 * ks + 6], C0[8 * ks + 7]); \
            w1.x = pk2(C1[8 * ks + 0], C1[8 * ks + 1]); w1.y = pk2(C1[8 * ks + 2], C1[8 * ks + 3]); w1.z = pk2(C1[8 * ks + 4], C1[8 * ks + 5]); w1.w = pk2(C1[8 * ks + 6], C1[8 * ks + 7]); \
            asm volatile("" : "+v"(w0), "+v"(w1)); \
            pf[ks] = __builtin_bit_cast(bf16x8, w0); pf[2 + ks] = __builtin_bit_cast(bf16x8, w1); } \
        asm volatile("" : "+v"(lrun)); \
        _Pragma("unroll") for (int i_ = 0; i_ < 12; ++i_) { __builtin_amdgcn_sched_group_barrier(0x008, 1, 0); __builtin_amdgcn_sched_group_barrier(0x002, 7, 0); } \
        __builtin_amdgcn_sched_barrier(0); \
        if (t_ + 1 >= 4 * qb) attn_mask(N0, N1, t_ + 1 - 4 * qb, qrel, hi); \
        if (w_ + 2 < NT) { LAS unsigned char* kd = lds + ATT_M3(m3 + 2 + wofs) * AT_KB; *(LAS u32x4*)(kd + dstA) = ga; if (hasB) *(LAS u32x4*)(kd + dstB) = gb; } \
        if (w_ + 1 < NT) *(LAS u32x4*)(lds + ATT_M3(m3 + 1 + wofs) * AT_VB + dstV) = gv; \
        if (!lead) ATT_BAR(); \
        m3 = ATT_M3(m3 + 1); \
    } while (0)
    for (int t = 0; t < NT; t += 2) {
        ATT_STEP(sA0, sA1, sB0, sB1, t);
        ATT_STEP(sB0, sB1, sA0, sA1, t + 1);
    }
    ATT_PART_B(sA0, sA1, ATT_M3(m3 + 2));
    __syncthreads();
#undef ATT_STEP
#undef ATT_PART_B
#undef ATT_BAR
#undef ATT_M3
    const float inv = 1.0f / swap32_sum(lrun);
    bf16_t* op = MIX + (size_t)qrow * DM + h * 64 + 4 * hi;
#pragma unroll
    for (int rg = 0; rg < 4; ++rg) {
        u32x2 w0, w1;
        w0.x = pk_bf16(o0[4 * rg] * inv, o0[4 * rg + 1] * inv); w0.y = pk_bf16(o0[4 * rg + 2] * inv, o0[4 * rg + 3] * inv);
        w1.x = pk_bf16(o1[4 * rg] * inv, o1[4 * rg + 1] * inv); w1.y = pk_bf16(o1[4 * rg + 2] * inv, o1[4 * rg + 3] * inv);
        *(u32x2*)(op + 8 * rg) = w0; *(u32x2*)(op + 32 + 8 * rg) = w1;
    }
}

__global__ void __launch_bounds__(NTHREADS, 2) mega_fwd(Params p) {
    extern __shared__ __attribute__((aligned(16))) unsigned char lds_raw[];
    LAS unsigned char* lds = (LAS unsigned char*)lds_raw;
    cg::grid_group grid = cg::this_grid();
    const int G = gridDim.x, bid = blockIdx.x;
    const int ngw = G * NWAVES;
#define LAUNDER_TID() int tid_l = threadIdx.x; asm volatile("" : "+v"(tid_l)); const int tid = tid_l, lane = tid & 63, wave = __builtin_amdgcn_readfirstlane(tid >> 6), gw = bid * NWAVES + wave; (void)tid; (void)lane; (void)gw;
    unsigned char* ws = p.ws;
    float* ssb = (float*)(ws + OFF_SS);
    bf16_t* XB = (bf16_t*)(ws + OFF_XB);
    const float* cs = (const float*)(ws + OFF_ROPE); const float* sn = cs + S * 16;
    int st = 0;
    const int lo = p.step_lo, hi_ = p.step_hi;
    const bool single = (lo == 0 && hi_ >= 1000);
#define RUN (st >= lo && st < hi_)
#define SYNC() do { if (single) xcd_barrier(xbar); ++st; } while (0)

    volatile LAS unsigned* xst = (volatile LAS unsigned*)(lds + LDS_MISC);
    if (threadIdx.x < 2) xst[threadIdx.x] = 0u;
    __syncthreads();
    XcdBarrier xbar; xbar.bar = (unsigned*)(ws + OFF_BAR); xbar.x = 0; xbar.st = xst;
    if (single) xbar = xcd_barrier_post((unsigned*)(ws + OFF_BAR), xst);
    if (p.step_hi < 0) grid.sync();
    if (RUN) { LAUNDER_TID(); prologue(p, lds, gw, ngw, lane, wave); }
    if (single) xcd_barrier(xbar);
    ++st;

    for (int l = 0; l < 4; ++l) {
        for (int sub = 0; sub < 3; ++sub) {
            const bool is_ffn = (sub != 1), even = ((l & 1) == 0);
            const int e = l >> 1;
            const int kin = l * 3 + sub;
            float* ss_in = ssb + (size_t)kin * S * 16; float* ss_out = ssb + (size_t)(kin + 1) * S * 16;
            float* ss_cq = ssb + (size_t)(13 + 3 * e) * S * 16; float* ss_ckv = ss_cq + (size_t)S * 16; float* ss_v = ss_ckv + (size_t)S * 16;
            if (is_ffn || !even) {
                if (RUN) {
                    pg8::Gemm g; pg8::StaticOrder So; EpiPair E;
                    g.A = XB; g.M = S; g.K = DM; g.lda = DM; g.ldb = DM;
                    if (is_ffn) { g.Bt = (const bf16_t*)(ws + OFF_WGU) + (size_t)(2 * l + (sub == 2)) * NGU * DM; g.N = NGU; E.O = (bf16_t*)(ws + OFF_ACT); E.ldo = FF; E.mode = 0; }
                    else { g.Bt = (const bf16_t*)(ws + OFF_WCIN) + (size_t)e * 3072 * DM; g.N = 2048; E.O = (bf16_t*)(ws + OFF_CZ); E.ldo = DM; E.mode = 1; }
                    E.ss = ss_in; E.inv_dim = 1.0f / DM;
                    So.init(S, g.N, G, bid);
                    pg8::gemm_phase<EpiPair, pg8::StaticOrder, true, true>(lds, g, So, E);
                    if (is_ffn) {
                        const int nfull = (64 * 22) % G, nwk = nfull ? G - nfull : G, wk = nfull ? bid - nfull : bid;
                        if (wk >= 0) {
                            LAUNDER_TID();
                            int a0, a1, b0 = 0, b1 = 0;
                            if (sub == 0) { a0 = 6 * l + 3; a1 = 6 * l + 6; if (l == 0) { b0 = 24; b1 = 28; } }
                            else if (l < 3) { const int ln = l + 1; a0 = 6 * ln; a1 = 6 * ln + 3; if (ln & 1) { b0 = 32 + 2 * (ln >> 1); b1 = b0 + 2; } else { b0 = 24 + 4 * (ln >> 1); b1 = b0 + 4; } }
                            else { a0 = 0; a1 = 0; }
                            convert_jobs(p, lds, a0, a1, wk * NWAVES + wave, nwk * NWAVES, lane, wave);
                            convert_jobs(p, lds, b0, b1, wk * NWAVES + wave, nwk * NWAVES, lane, wave);
                        }
                    }
                }
            }
            if (!is_ffn) {
                const int ng = even ? 3 : 1;
                for (int gi = 0; gi < ng; ++gi) {
                    if (RUN) {
                        pg8::Gemm g; pg8::StaticOrder So; EpiRow E;
                        g.M = S; E.split_tiles = 0; E.split_stride = 0; E.gelu_from = 1 << 20; E.rope_pn = -1; E.rope_bj = -1; E.rope_wc = 0; E.cs = cs; E.sn = sn;
                        E.stat_map = 0ull; E.stb = ss_cq;
                        if (!even) {
                            g.A = XB; g.lda = DM; g.K = DM; g.ldb = DM; g.Bt = (const bf16_t*)(ws + OFF_WCIN) + (size_t)e * 3072 * DM + (size_t)2048 * DM; g.N = 1024;
                            E.O = (bf16_t*)(ws + OFF_BG); E.ldo = DM; E.ss = ss_in; E.inv_dim = 1.0f / DM; E.nsl = 16;
                        } else if (gi == 0) {
                            g.A = XB; g.lda = DM; g.K = DM; g.ldb = DM; g.Bt = (const bf16_t*)(ws + OFF_WIN) + (size_t)e * PW * DM; g.N = PW;
                            E.O = (bf16_t*)(ws + OFF_P); E.ldo = PW; E.ss = ss_in; E.inv_dim = 1.0f / DM; E.nsl = 16;
                            E.gelu_from = 3; E.rope_pn = 2; E.rope_bj = 1; E.rope_wc = 0;
                            E.stat_map = 0x1ull | (0x1ull << 4) | (0x1ull << 8) | (0x2ull << 12) | (0x2ull << 16) | (0x3ull << 40) | (0x3ull << 44) | (0x3ull << 48) | (0x3ull << 52);
                        } else if (gi == 1) {
                            g.A = (const bf16_t*)(ws + OFF_P) + P_CKV; g.lda = PW; g.K = 256; g.ldb = 256; g.Bt = (const bf16_t*)(ws + OFF_WUKV) + (size_t)e * 1024 * 256; g.N = 1024;
                            E.O = (bf16_t*)(ws + OFF_KN); E.ldo = 512; E.split_tiles = 2; E.split_stride = (OFF_V - OFF_KN) / 2; E.ss = ss_ckv; E.inv_dim = 1.0f / 256.0f; E.nsl = 8;
                        } else {
                            g.A = (const bf16_t*)(ws + OFF_P) + P_CQ; g.lda = PW; g.K = 384; g.ldb = 384; g.Bt = (const bf16_t*)(ws + OFF_WUQ) + (size_t)e * 768 * 384; g.N = 768;
                            E.O = (bf16_t*)(ws + OFF_Q); E.ldo = QW; E.ss = ss_cq; E.inv_dim = 1.0f / 384.0f; E.nsl = 12; E.rope_pn = 2; E.rope_bj = -1;
                        }
                        So.init(S, g.N, G, bid);
                        pg8::gemm_phase<EpiRow, pg8::StaticOrder, true, true>(lds, g, So, E);
                    }
                    if (even && gi == 0) SYNC();
                }
            }
            SYNC();
            if (!is_ffn) {
                if (RUN) {
                    if (even) {
                        const bf16_t* P = (const bf16_t*)(ws + OFF_P);
                        bf16_t* MIX = (bf16_t*)(ws + OFF_MIX);
                        for (int u = bid; u < 256; u += G)
                            sgu_unit(lds, u, P, ss_v, p.in[17] + (size_t)e * 8 * 128 * 128, p.in[18] + (size_t)e * 8 * 128, p.in[16] + (size_t)e * 512, MIX);
                        for (int u = bid; u < 256; u += G) {
                            const int h = u & 7, s = u >> 3;
                            attn_unit(lds, (const bf16_t*)(ws + OFF_Q), (const bf16_t*)(ws + OFF_KN), P, (const bf16_t*)(ws + OFF_V), MIX, h, 63 - s);
                            attn_unit(lds, (const bf16_t*)(ws + OFF_Q), (const bf16_t*)(ws + OFF_KN), P, (const bf16_t*)(ws + OFF_V), MIX, h, s);
                        }
                    } else {
                        const bf16_t* CZ = (const bf16_t*)(ws + OFF_CZ); const bf16_t* BG = (const bf16_t*)(ws + OFF_BG); bf16_t* Gb = (bf16_t*)(ws + OFF_G);
                        const float* cw = p.in[21] + (size_t)e * 3 * DM;
                        LAUNDER_TID();
                        for (int idx = bid * NTHREADS + tid; idx < S * 128; idx += G * NTHREADS) {
                            const int t = idx >> 7, c8 = (idx & 127) * 8;
                            const u32x4 z0 = *(const u32x4*)(CZ + (size_t)t * DM + c8);
                            const u32x4 z1 = t >= 1 ? *(const u32x4*)(CZ + (size_t)(t - 1) * DM + c8) : (u32x4){0u, 0u, 0u, 0u};
                            const u32x4 z2 = t >= 2 ? *(const u32x4*)(CZ + (size_t)(t - 2) * DM + c8) : (u32x4){0u, 0u, 0u, 0u};
                            const u32x4 bg = *(const u32x4*)(BG + (size_t)t * DM + c8);
                            float o[8];
#pragma unroll
                            for (int i = 0; i < 4; ++i) {
#pragma unroll
                                for (int hlf = 0; hlf < 2; ++hlf) {
                                    const int c = c8 + 2 * i + hlf;
                                    const float a0 = hlf ? __uint_as_float(z0[i] & 0xffff0000u) : __uint_as_float(z0[i] << 16);
                                    const float a1 = hlf ? __uint_as_float(z1[i] & 0xffff0000u) : __uint_as_float(z1[i] << 16);
                                    const float a2 = hlf ? __uint_as_float(z2[i] & 0xffff0000u) : __uint_as_float(z2[i] << 16);
                                    const float bb = hlf ? __uint_as_float(bg[i] & 0xffff0000u) : __uint_as_float(bg[i] << 16);
                                    o[2 * i + hlf] = bb * (cw[c] * a2 + cw[DM + c] * a1 + cw[2 * DM + c] * a0);
                                }
                            }
                            u32x4 w; w.x = pk_bf16(o[0], o[1]); w.y = pk_bf16(o[2], o[3]); w.z = pk_bf16(o[4], o[5]); w.w = pk_bf16(o[6], o[7]);
                            *(u32x4*)(Gb + (size_t)t * DM + c8) = w;
                        }
                    }
                }
                SYNC();
            }
            if (RUN) {
                pg8::Gemm g; pg8::StaticOrder So; EpiRes E;
                g.M = S; g.N = DM;
                if (is_ffn) { g.A = (const bf16_t*)(ws + OFF_ACT); g.K = FF; g.lda = FF; g.ldb = FF; g.Bt = (const bf16_t*)(ws + OFF_WD) + (size_t)(2 * l + (sub == 2)) * DM * FF; E.alpha = 0.5f; }
                else if (even) { g.A = (const bf16_t*)(ws + OFF_MIX); g.K = DM; g.lda = DM; g.ldb = DM; g.Bt = (const bf16_t*)(ws + OFF_WOUT) + (size_t)e * DM * DM; E.alpha = 1.0f; }
                else { g.A = (const bf16_t*)(ws + OFF_G); g.K = DM; g.lda = DM; g.ldb = DM; g.Bt = (const bf16_t*)(ws + OFF_WCOUT) + (size_t)e * DM * DM; E.alpha = 1.0f; }
                E.XB = XB; E.ss_out = ss_out;
                So.init(S, DM, G, bid);
                pg8::gemm_phase<EpiRes, pg8::StaticOrder, true, true>(lds, g, So, E);
            }
            SYNC();
        }
    }
    if (RUN) {
        const float* gn = p.in[23];
        LAUNDER_TID();
        for (int row = gw; row < S; row += ngw) {
            const u32x2* xr = (const u32x2*)(XB + (size_t)row * DM) + lane;
            f32x4 v[4]; float s = 0.f;
#pragma unroll
            for (int j = 0; j < 4; ++j) {
                const u32x2 w = xr[64 * j];
                v[j] = (f32x4){__uint_as_float(w.x << 16), __uint_as_float(w.x & 0xffff0000u), __uint_as_float(w.y << 16), __uint_as_float(w.y & 0xffff0000u)};
                s += (v[j][0] * v[j][0] + v[j][1] * v[j][1]) + (v[j][2] * v[j][2] + v[j][3] * v[j][3]);
            }
#pragma unroll
            for (int o = 1; o < 64; o <<= 1) s += __shfl_xor(s, o);
            const float rs = rsqrtf(s * (1.0f / DM) + EPS);
            f32x4* orow = (f32x4*)(p.out + (size_t)row * DM) + lane;
#pragma unroll
            for (int j = 0; j < 4; ++j) { const f32x4 gg = ((const f32x4*)gn + lane)[64 * j]; orow[64 * j] = v[j] * rs * gg; }
        }
    }
#undef RUN
#undef SYNC
}

#ifndef MK_MULTI
#define MK_MULTI 0
#endif
extern "C" void kernel_launch(void* const* d_in, const int* in_sizes, int n_in, void* d_out, int out_size, void* d_ws, size_t ws_size, hipStream_t stream) {
    static int grid = 0;
    if (grid == 0) {
        if (n_in != 24 || out_size != S * DM || ws_size < WS_END) { fprintf(stderr, "kernel_launch: unexpected problem (n_in %d out %d ws %zu)\n", n_in, out_size, ws_size); grid = -1; return; }
        int dev = 0, cus = 0, per_cu = 0;
        hipGetDevice(&dev);
        hipDeviceGetAttribute(&cus, hipDeviceAttributeMultiprocessorCount, dev);
        if (hipFuncSetAttribute((const void*)mega_fwd, hipFuncAttributeMaxDynamicSharedMemorySize, LDS_BYTES) != hipSuccess) { fprintf(stderr, "hipFuncSetAttribute failed\n"); grid = -1; return; }
        if (hipOccupancyMaxActiveBlocksPerMultiprocessor(&per_cu, (const void*)mega_fwd, NTHREADS, LDS_BYTES) != hipSuccess || per_cu < 1) { fprintf(stderr, "occupancy query failed (%d)\n", per_cu); per_cu = 1; }
        (void)hipGetLastError();
        if (per_cu > 1) per_cu = 1;
        grid = cus * per_cu;
    }
    if (grid < 0) return;
    (void)hipMemsetAsync((char*)d_ws + OFF_BAR, 0, XCD_BAR_WORDS * sizeof(unsigned), stream);
    Params p{};
    for (int i = 0; i < 24; ++i) p.in[i] = (const float*)d_in[i];
    p.out = (float*)d_out; p.ws = (unsigned char*)d_ws;
    for (int i = 0; i < 16; ++i) p.inv_freq[i] = (float)pow(10000.0, -(double)i / 16.0);
#if MK_MULTI
    for (int s = 0; s < 40; ++s) {
        p.step_lo = s; p.step_hi = s + 1;
        hipLaunchKernelGGL(mega_fwd, dim3(grid), dim3(NTHREADS), LDS_BYTES, stream, p);
    }
#else
    p.step_lo = 0; p.step_hi = 1000;
    void* args[] = {&p};
    hipError_t e = hipLaunchCooperativeKernel((const void*)mega_fwd, dim3(grid), dim3(NTHREADS), args, LDS_BYTES, stream);
    if (e != hipSuccess) fprintf(stderr, "cooperative launch failed: %s (grid %d)\n", hipGetErrorString(e), grid);
#endif
}
```

```cpp
#include <hip/hip_runtime.h>
#include <hip/hip_cooperative_groups.h>
#include <cstdio>
#include <cstdint>
#include <cmath>
namespace cg = cooperative_groups;
namespace pg8 {
#define PG8_LAS __attribute__((address_space(3)))
typedef unsigned short bf16_t;
typedef short bf16x8 __attribute__((ext_vector_type(8)));
typedef float f32x4 __attribute__((ext_vector_type(4)));
typedef unsigned u32x4 __attribute__((ext_vector_type(4)));
constexpr int BM = 256, BK = 64, HALF = 128, HTB = HALF * BK * 2  , STAGE_BYTES = 8 * HTB, NXCD = 8, WGM = 8;

__host__ __device__ __forceinline__ int lds_byte(int r, int c) { const int st = (r >> 4) * 2 + (c >> 5), rr = r & 15, cc = c & 31, ob = rr * 64 + cc * 2; return st * 1024 + (ob ^ (((ob >> 9) & 1) << 5)); }
__host__ __device__ __forceinline__ void stage_rc(int b, int& R, int& C) { const int st = b / 1024, sb = b % 1024, swz = sb ^ (((sb >> 9) & 1) << 5); R = (st >> 1) * 16 + swz / 64; C = (st & 1) * 32 + (swz % 64) / 2; }
__host__ __device__ __forceinline__ int perm32(int rho) { const int n = rho >> 4, i = rho & 15; return 8 * (i >> 2) + 4 * n + (i & 3); }

struct Unit { int pm, pn; };
struct Gemm { const bf16_t* A; const bf16_t* Bt; int M, N, K, lda, ldb; };

struct StaticOrder {
    int nM, nN, nwg, G, c;
    __host__ __device__ void init(int M, int N, int G_, int c_) { nM = M / BM; nN = N / BM; nwg = nM * nN; G = G_; c = c_; }
    __host__ __device__ bool next(int i, Unit& u) const {
        const long L = (long)i * G + c; if (L >= nwg) return false;
        int wgid = (int)L; { const int q = nwg / NXCD, r = nwg % NXCD, xcd = wgid % NXCD, off = wgid / NXCD; wgid = (xcd < r ? xcd * (q + 1) : r * (q + 1) + (xcd - r) * q) + off; }
        const int nig = WGM * nN, gid = wgid / nig, fm = gid * WGM, gsz = (nM - fm) < WGM ? (nM - fm) : WGM;
        u.pm = fm + ((wgid % nig) % gsz); u.pn = (wgid % nig) / gsz; return true;
    }
    __device__ __forceinline__ void a_ready(const Unit&) const {}
    __device__ __forceinline__ void done(const Unit&) const {}
};

__device__ __forceinline__ unsigned cvt_pk_bf16(float lo, float hi) { unsigned r; asm volatile("v_cvt_pk_bf16_f32 %0, %1, %2" : "=v"(r) : "v"(lo), "v"(hi)); return r; }
typedef float f32x2 __attribute__((ext_vector_type(2)));
__device__ __forceinline__ f32x2 gelu_pk(f32x2 v) {
    const f32x2 av = __builtin_elementwise_abs(v), d = av * 0.2316418882f + 1.0f;
    f32x2 t; t.x = __builtin_amdgcn_rcpf(d.x); t.y = __builtin_amdgcn_rcpf(d.y);
    f32x2 q = t * 0.5307027145f + (-0.7265760135f); q = q * t + 0.7107068705f; q = q * t + (-0.142248368f); q = q * t + 0.127414796f; q = q * t;
    const f32x2 s = (v * v) * (-0.72134752044f);
    f32x2 e; e.x = __builtin_amdgcn_exp2f(s.x); e.y = __builtin_amdgcn_exp2f(s.y);
    const f32x2 m = v * (q * e), r = v - m;
    f32x2 o; o.x = v.x < 0.f ? m.x : r.x; o.y = v.y < 0.f ? m.y : r.y; return o;
}
template <class Epi, class Sched, bool ALIGN_EPI = false, bool SP2 = false>
__device__ __forceinline__ void gemm_phase(PG8_LAS unsigned char* lds, const Gemm g, const Sched& S, const Epi& E) {
    int tid_l = threadIdx.x; asm volatile("" : "+v"(tid_l)); const int tid = tid_l, wid = __builtin_amdgcn_readfirstlane(tid >> 6), lane = tid & 63, wr = wid >> 2, wc = wid & 3, fr = lane & 15, fq = lane >> 4;
    const int K = g.K, nt = K / BK;
    unsigned voffA[2], voffB[2];
#pragma unroll
    for (int i = 0; i < 2; ++i) { int R, C; stage_rc(tid * 16 + i * 8192, R, C); const int Rb = Epi::PERM ? ((R & ~31) + perm32(R & 31)) : R;
        voffA[i] = (unsigned)(R * g.lda + C) * 2u; voffB[i] = (unsigned)(Rb * g.ldb + C) * 2u; }
    const size_t kstep = (size_t)(BK * 2);
    const size_t hstepA = (size_t)HALF * g.lda * 2, hstepB = (size_t)HALF * g.ldb * 2;
    const size_t tstepA = 2 * hstepA, tstepB = 2 * hstepB;
    const unsigned ldsw = (unsigned)wid * 1024u;
    const int aoff = lds_byte(wr * 64 + fr, fq * 8), boff = lds_byte(wc * 32 + fr, fq * 8);
#define PG8_SA(b, h) (((b) * 2 + (h)) * HTB)
#define PG8_SB(b, h) ((4 + (b) * 2 + (h)) * HTB)
#define PG8_STAGE(bufoff, gbase, voff) do { _Pragma("unroll") for (int _i = 0; _i < 2; ++_i) \
        __builtin_amdgcn_global_load_lds((const unsigned*)((const char*)(gbase) + (voff)[_i]), (PG8_LAS unsigned*)(lds + (bufoff) + ldsw + _i * 8192), 16, 0, 0); } while (0)
#define PG8_LDA(dst, b, h) do { _Pragma("unroll") for (int m = 0; m < 4; ++m) _Pragma("unroll") for (int k = 0; k < 2; ++k) dst[m][k] = *(const PG8_LAS bf16x8*)(lds + PG8_SA(b, h) + aoff + m * 2048 + k * 1024); } while (0)
#define PG8_LDB(dst, b, h) do { _Pragma("unroll") for (int n = 0; n < 2; ++n) _Pragma("unroll") for (int k = 0; k < 2; ++k) dst[n][k] = *(const PG8_LAS bf16x8*)(lds + PG8_SB(b, h) + boff + n * 2048 + k * 1024); } while (0)
#define PG8_MMA(ai, bj, At, Bt) do { __builtin_amdgcn_s_setprio(1); _Pragma("unroll") for (int m = 0; m < 4; ++m) _Pragma("unroll") for (int n = 0; n < 2; ++n) _Pragma("unroll") for (int k = 0; k < 2; ++k) \
        acc[ai][bj][m][n] = __builtin_amdgcn_mfma_f32_16x16x32_bf16(Bt[n][k], At[m][k], acc[ai][bj][m][n], 0, 0, 0); __builtin_amdgcn_s_setprio(0); } while (0)
#define PG8_WAIT_V(n) asm volatile("s_waitcnt vmcnt(" #n ")" ::: "memory")
#define PG8_WAIT_L(n) asm volatile("s_waitcnt lgkmcnt(" #n ")" ::: "memory")
#define PG8_BAR __builtin_amdgcn_s_barrier()
#define PG8_SCHED __builtin_amdgcn_sched_barrier(0)
    Unit cur, nxt; int ui = 0;
    if (!S.next(0, cur)) return;
    f32x4 acc[2][2][4][2];
#pragma unroll
    for (int a = 0; a < 2; ++a)
#pragma unroll
        for (int b = 0; b < 2; ++b)
#pragma unroll
            for (int m = 0; m < 4; ++m)
#pragma unroll
                for (int n = 0; n < 2; ++n) acc[a][b][m][n] = (f32x4){0.f, 0.f, 0.f, 0.f};
    bf16x8 At[4][2], B0[2][2], B1[2][2];
    const char* cA = (const char*)g.A + (size_t)cur.pm * tstepA; const char* cB = (const char*)g.Bt + (size_t)cur.pn * tstepB;
    S.a_ready(cur);
    if constexpr (SP2) {
        PG8_STAGE(PG8_SB(0, 0), cB, voffB); PG8_STAGE(PG8_SB(0, 1), cB + hstepB, voffB); PG8_STAGE(PG8_SA(0, 0), cA, voffA); PG8_STAGE(PG8_SA(0, 1), cA + hstepA, voffA);
        if (wr == 1) PG8_BAR;
        PG8_WAIT_V(2); PG8_BAR;
        PG8_STAGE(PG8_SB(1, 0), cB + kstep, voffB); PG8_STAGE(PG8_SA(1, 0), cA + kstep, voffA); PG8_STAGE(PG8_SB(1, 1), cB + hstepB + kstep, voffB);
        PG8_WAIT_V(6); PG8_BAR;
    } else {
        PG8_STAGE(PG8_SB(0, 0), cB, voffB); PG8_STAGE(PG8_SA(0, 0), cA, voffA); PG8_STAGE(PG8_SB(0, 1), cB + hstepB, voffB); PG8_STAGE(PG8_SA(0, 1), cA + hstepA, voffA);
        if (wr == 1) PG8_BAR;
        PG8_WAIT_V(4); PG8_BAR;
        PG8_STAGE(PG8_SB(1, 0), cB + kstep, voffB); PG8_STAGE(PG8_SA(1, 0), cA + kstep, voffA); PG8_STAGE(PG8_SB(1, 1), cB + hstepB + kstep, voffB);
        PG8_WAIT_V(6); PG8_BAR;
    }
    for (;;) {
        const bool has_next = S.next(ui + 1, nxt);
        const char* nA = has_next ? (const char*)g.A + (size_t)nxt.pm * tstepA : cA; const char* nB = has_next ? (const char*)g.Bt + (size_t)nxt.pn * tstepB : cB;
        for (int t = 0; t < nt; t += 2) {
            const bool last = (t == nt - 2);
            const char* a1 = cA + (size_t)(t + 1) * kstep;
            const char* a2 = last ? nA : cA + (size_t)(t + 2) * kstep; const char* b2 = last ? nB : cB + (size_t)(t + 2) * kstep;
            const char* a3 = a2 + kstep; const char* b3 = b2 + kstep;
            if (last && has_next) S.a_ready(nxt);
            if constexpr (SP2) {
            PG8_LDB(B0, 0, 0); PG8_LDB(B1, 0, 1); PG8_SCHED; PG8_LDA(At, 0, 0); PG8_STAGE(PG8_SA(1, 1), a1 + hstepA, voffA);
            PG8_WAIT_V(8); PG8_WAIT_L(0); PG8_BAR; PG8_MMA(0, 0, At, B0); PG8_MMA(0, 1, At, B1); PG8_BAR; PG8_SCHED;
            PG8_LDA(At, 0, 1); PG8_STAGE(PG8_SB(0, 0), b2, voffB); PG8_STAGE(PG8_SB(0, 1), b2 + hstepB, voffB); PG8_STAGE(PG8_SA(0, 0), a2, voffA);
            PG8_WAIT_V(8); PG8_WAIT_L(0); PG8_BAR; PG8_MMA(1, 0, At, B0); PG8_MMA(1, 1, At, B1); PG8_BAR; PG8_SCHED;
            PG8_LDB(B0, 1, 0); PG8_LDB(B1, 1, 1); PG8_SCHED; PG8_LDA(At, 1, 0); PG8_STAGE(PG8_SA(0, 1), a2 + hstepA, voffA);
            PG8_WAIT_V(8); PG8_WAIT_L(0); PG8_BAR; PG8_MMA(0, 0, At, B0); PG8_MMA(0, 1, At, B1); PG8_BAR; PG8_SCHED;
            PG8_LDA(At, 1, 1); PG8_STAGE(PG8_SB(1, 0), b3, voffB); PG8_STAGE(PG8_SB(1, 1), b3 + hstepB, voffB); PG8_STAGE(PG8_SA(1, 0), a3, voffA);
            PG8_WAIT_V(8); PG8_WAIT_L(0); PG8_BAR; PG8_MMA(1, 0, At, B0); PG8_MMA(1, 1, At, B1); PG8_BAR; PG8_SCHED;
            } else {
            PG8_LDB(B0, 0, 0); PG8_SCHED; PG8_LDA(At, 0, 0); PG8_STAGE(PG8_SA(1, 1), a1 + hstepA, voffA);
            PG8_WAIT_L(8); PG8_BAR; PG8_WAIT_L(0); PG8_MMA(0, 0, At, B0); PG8_BAR; PG8_SCHED;
            PG8_LDB(B1, 0, 1); PG8_STAGE(PG8_SB(0, 0), b2, voffB);
            PG8_BAR; PG8_WAIT_L(0); PG8_MMA(0, 1, At, B1); PG8_BAR;
            PG8_LDA(At, 0, 1); PG8_STAGE(PG8_SA(0, 0), a2, voffA);
            PG8_BAR; PG8_WAIT_L(0); PG8_MMA(1, 0, At, B0); PG8_BAR; PG8_SCHED;
            PG8_STAGE(PG8_SB(0, 1), b2 + hstepB, voffB);
            PG8_WAIT_V(6); PG8_BAR; PG8_MMA(1, 1, At, B1); PG8_BAR;
            PG8_LDB(B0, 1, 0); PG8_SCHED; PG8_LDA(At, 1, 0); PG8_STAGE(PG8_SA(0, 1), a2 + hstepA, voffA);
            PG8_WAIT_L(8); PG8_BAR; PG8_WAIT_L(0); PG8_MMA(0, 0, At, B0); PG8_BAR; PG8_SCHED;
            PG8_LDB(B1, 1, 1); PG8_STAGE(PG8_SB(1, 0), b3, voffB);
            PG8_BAR; PG8_WAIT_L(0); PG8_MMA(0, 1, At, B1); PG8_BAR;
            PG8_LDA(At, 1, 1); PG8_STAGE(PG8_SA(1, 0), a3, voffA);
            PG8_BAR; PG8_WAIT_L(0); PG8_MMA(1, 0, At, B0); PG8_BAR; PG8_SCHED;
            PG8_STAGE(PG8_SB(1, 1), b3 + hstepB, voffB);
            PG8_WAIT_V(6); PG8_BAR; PG8_MMA(1, 1, At, B1); PG8_BAR;
            }
        }
        if constexpr (ALIGN_EPI) { if (wr == 0) PG8_BAR; }
        if constexpr (!Epi::AFTER_DRAIN) { E(acc, cur, wr, wc, fr, fq); S.done(cur); }
        if (!has_next) break;
#pragma unroll
        for (int a = 0; a < 2; ++a)
#pragma unroll
            for (int b = 0; b < 2; ++b)
#pragma unroll
                for (int m = 0; m < 4; ++m)
#pragma unroll
                    for (int n = 0; n < 2; ++n) acc[a][b][m][n] = (f32x4){0.f, 0.f, 0.f, 0.f};
        cur = nxt; cA = nA; cB = nB; ++ui;
        if constexpr (ALIGN_EPI) { if (wr == 1) PG8_BAR; }
    }
    PG8_WAIT_V(0);
    if constexpr (!ALIGN_EPI) { if (wr == 0) PG8_BAR; }
    PG8_BAR;
    if constexpr (Epi::AFTER_DRAIN) { E.fused(acc, cur, wr, wc, fr, fq, lds, wid, lane); S.done(cur); }
#undef PG8_SA
#undef PG8_SB
#undef PG8_STAGE
#undef PG8_LDA
#undef PG8_LDB
#undef PG8_MMA
#undef PG8_WAIT_V
#undef PG8_WAIT_L
#undef PG8_BAR
#undef PG8_SCHED
}
}
#define LAS __attribute__((address_space(3)))
#define XB_TMO      128
#define XB_XCNT(j)  (256  + 64 * (j))
#define XB_XSUB(j)  (1280 + 64 * (j))
#define XB_XGEN(j)  (2304 + 64 * (j))
#define XB_TOP      3328
#define XB_TOPGEN   3392
#define XCD_BAR_WORDS 3456
#define XB_SPIN_CAP (1u << 18)

__device__ __forceinline__ unsigned xb_ld(unsigned* p)              { return __hip_atomic_load(p, __ATOMIC_RELAXED, __HIP_MEMORY_SCOPE_AGENT); }
__device__ __forceinline__ unsigned xb_add(unsigned* p, unsigned v) { return __hip_atomic_fetch_add(p, v, __ATOMIC_RELAXED, __HIP_MEMORY_SCOPE_AGENT); }
__device__ __forceinline__ unsigned xb_xcc_id() { return (unsigned)__builtin_amdgcn_s_getreg((3 << 11) | 20) & 0xFu; }
#define XB_SPIN(cond, bar) do { unsigned _sp = 0; while (cond) { __builtin_amdgcn_s_sleep(1); \
    if ((++_sp & 255u) == 0u) { if (xb_ld(&(bar)[XB_TMO])) break; if (_sp > XB_SPIN_CAP) { atomicAdd(&(bar)[XB_TMO], 1u); break; } } } } while (0)

struct XcdBarrier {
    unsigned* bar; unsigned x;
    volatile LAS unsigned* st;
};

__device__ __forceinline__ XcdBarrier xcd_barrier_post(unsigned* bar, volatile LAS unsigned* st) {
    XcdBarrier b; b.bar = bar; b.x = xb_xcc_id(); b.st = st;
    if (threadIdx.x == 0) (void)xb_add(&bar[XB_XCNT(b.x)], 1u);
    return b;
}
__device__ __forceinline__ void xcd_barrier_complete(unsigned* bar, unsigned x, unsigned& nloc, unsigned& nx) {
    const unsigned G = gridDim.x * gridDim.y * gridDim.z;
    unsigned sum, cnt, mine, sp = 0u;
    for (;;) {
        sum = 0u; cnt = 0u; mine = 0u;
#pragma unroll
        for (unsigned j = 0; j < 16; ++j) { const unsigned c = xb_ld(&bar[XB_XCNT(j)]); sum += c; cnt += (c > 0u) ? 1u : 0u; mine = (j == x) ? c : mine; }
        if (sum == G) break;
        __builtin_amdgcn_s_sleep(1);
        if ((++sp & 255u) == 0u) { if (xb_ld(&bar[XB_TMO])) break; if (sp > XB_SPIN_CAP) { atomicAdd(&bar[XB_TMO], 1u); break; } }
    }
    nloc = mine > 0u ? mine : 1u; nx = cnt > 0u ? cnt : 1u;
}

__device__ __forceinline__ void xcd_barrier(const XcdBarrier& b) {
    asm volatile("s_waitcnt vmcnt(0)" ::: "memory");
    __syncthreads();
    if (threadIdx.x == 0) {
        unsigned* bar = b.bar;
        __builtin_amdgcn_s_waitcnt(0);
        unsigned nloc = b.st[0], nx = b.st[1];
        if (nloc == 0u) { xcd_barrier_complete(bar, b.x, nloc, nx); b.st[0] = nloc; b.st[1] = nx; }
        const unsigned old = xb_add(&bar[XB_XSUB(b.x)], 1u);
        const unsigned gen = old / nloc;
        if (old + 1u == (gen + 1u) * nloc) {
            __builtin_amdgcn_fence(__ATOMIC_RELEASE, "agent");
            asm volatile("s_waitcnt vmcnt(0)" ::: "memory");
            const unsigned og = xb_add(&bar[XB_TOP], 1u);
            const unsigned tg = og / nx;
            if (og + 1u == (tg + 1u) * nx) xb_add(&bar[XB_TOPGEN], 1u);
            else XB_SPIN(xb_ld(&bar[XB_TOPGEN]) == tg, bar);
            __builtin_amdgcn_fence(__ATOMIC_ACQUIRE, "agent");
            xb_add(&bar[XB_XGEN(b.x)], 1u);
            asm volatile("s_waitcnt vmcnt(0)" ::: "memory");
        } else {
            XB_SPIN(xb_ld(&bar[XB_XGEN(b.x)]) == gen, bar);
            __builtin_amdgcn_fence(__ATOMIC_ACQUIRE, "agent");
            asm volatile("s_waitcnt vmcnt(0)" ::: "memory");
        }
    }
    __syncthreads();
}

typedef unsigned short bf16_t;
typedef short bf16x8 __attribute__((ext_vector_type(8)));
typedef short s16x4 __attribute__((ext_vector_type(4)));
typedef float f32x4 __attribute__((ext_vector_type(4)));
typedef float f32x2 __attribute__((ext_vector_type(2)));
typedef float f32x16 __attribute__((ext_vector_type(16)));
typedef unsigned u32x4 __attribute__((ext_vector_type(4)));
typedef unsigned u32x2 __attribute__((ext_vector_type(2)));

constexpr int S = 16384, DM = 1024, FF = 2816, NGU = 2 * FF;
constexpr int PW = 1792;
constexpr int P_CQ = 0, P_CKV = 384, P_KR = 640, P_U = 768, P_V = 1280;
constexpr int QW = 768;
constexpr float EPS = 1e-6f;
constexpr int NTHREADS = 512, NWAVES = 8;
constexpr int LDS_BYTES = 147456;
constexpr int LDS_MISC = 131072;

constexpr size_t MiB = (size_t)1 << 20;
constexpr size_t OFF_SS = 342 * MiB;
constexpr size_t OFF_ROPE = 2 * MiB;
constexpr size_t OFF_WGU = 4 * MiB;
constexpr size_t OFF_WD = 92 * MiB;
constexpr size_t OFF_WIN = 136 * MiB;
constexpr size_t OFF_WUQ = 143 * MiB;
constexpr size_t OFF_WUKV = 145 * MiB;
constexpr size_t OFF_WOUT = 146 * MiB;
constexpr size_t OFF_WCIN = 150 * MiB;
constexpr size_t OFF_WCOUT = 162 * MiB;
constexpr size_t OFF_XB = 166 * MiB;
constexpr size_t OFF_ACT = 198 * MiB;
constexpr size_t OFF_P = OFF_ACT, OFF_Q = OFF_ACT + 56 * MiB, OFF_KN = OFF_ACT + 80 * MiB, OFF_V = OFF_ACT + 96 * MiB, OFF_MIX = OFF_ACT + 112 * MiB;
constexpr size_t OFF_CZ = OFF_ACT, OFF_BG = OFF_ACT + 32 * MiB, OFF_G = OFF_ACT + 64 * MiB;
constexpr size_t OFF_BAR = 361 * MiB;
constexpr size_t WS_END = 362 * MiB;

struct Params {
    const float* in[24];
    float* out;
    unsigned char* ws;
    float inv_freq[16];
    int step_lo, step_hi;
};

__device__ __forceinline__ float bf2f(unsigned short b) { return __uint_as_float((unsigned)b << 16); }
__device__ __forceinline__ unsigned pk_bf16(float lo, float hi) { return pg8::cvt_pk_bf16(lo, hi); }
__device__ __forceinline__ int crow(int r, int h) { return (r & 3) + 8 * (r >> 2) + 4 * h; }
__device__ __forceinline__ float swap32_max(float v) {
    auto rr = __builtin_amdgcn_permlane32_swap(__float_as_uint(v), __float_as_uint(v), false, false);
    return fmaxf(__uint_as_float(rr[0]), __uint_as_float(rr[1]));
}
__device__ __forceinline__ float swap32_sum(float v) {
    auto rr = __builtin_amdgcn_permlane32_swap(__float_as_uint(v), __float_as_uint(v), false, false);
    return __uint_as_float(rr[0]) + __uint_as_float(rr[1]);
}

__device__ __forceinline__ float row_ss(const float* st, int row, int nsl) {
    const f32x4* q = (const f32x4*)(st + (size_t)row * 16);
    const f32x4 a = q[0], b = q[1];
    float s = ((a[0] + a[1]) + (a[2] + a[3])) + ((b[0] + b[1]) + (b[2] + b[3]));
    if (nsl > 8) { const f32x4 c = q[2]; s += (c[0] + c[1]) + (c[2] + c[3]); }
    if (nsl > 12) { const f32x4 d = q[3]; s += (d[0] + d[1]) + (d[2] + d[3]); }
    return s;
}
__device__ __forceinline__ f32x4 row_ss_part(const float* st, int row, int nsl, int fq) {
    return (4 * fq < nsl) ? ((const f32x4*)(st + (size_t)row * 16))[fq] : (f32x4){0.f, 0.f, 0.f, 0.f};
}
__device__ __forceinline__ float row_ss_fin(const f32x4 v) {
    float s = (v[0] + v[1]) + (v[2] + v[3]);
    s += __shfl_xor(s, 16); s += __shfl_xor(s, 32);
    return s;
}

struct EpiPair {
    static constexpr bool PERM = true, AFTER_DRAIN = false;
    bf16_t* O; int ldo; const float* ss; float inv_dim; int mode;
    __device__ __forceinline__ void operator()(const f32x4 (&acc)[2][2][4][2], const pg8::Unit& u, int wr, int wc, int fr, int fq) const {
        const int row0 = u.pm * 256 + wr * 64 + fr, col0 = u.pn * 128 + wc * 32 + 8 * fq;
        f32x4 sp[2][4]; float rsv[2][4];
#pragma unroll
        for (int ai = 0; ai < 2; ++ai)
#pragma unroll
            for (int m = 0; m < 4; ++m) sp[ai][m] = row_ss_part(ss, row0 + ai * 128 + m * 16, 16, fq);
#pragma unroll
        for (int ai = 0; ai < 2; ++ai)
#pragma unroll
            for (int m = 0; m < 4; ++m) rsv[ai][m] = rsqrtf(row_ss_fin(sp[ai][m]) * inv_dim + EPS);
#pragma unroll
        for (int ai = 0; ai < 2; ++ai)
#pragma unroll
            for (int m = 0; m < 4; ++m) {
                const int row = row0 + ai * 128 + m * 16;
                const float rs = rsv[ai][m];
                float h[8];
#pragma unroll
                for (int n = 0; n < 2; ++n)
#pragma unroll
                    for (int j = 0; j < 4; ++j) {
                        const float a = acc[ai][0][m][n][j] * rs, b = acc[ai][1][m][n][j] * rs;
                        h[n * 4 + j] = (mode == 0) ? a * __builtin_amdgcn_rcpf(1.0f + __expf(-a)) * b : a * b;
                    }
                u32x4 w; w.x = pk_bf16(h[0], h[1]); w.y = pk_bf16(h[2], h[3]); w.z = pk_bf16(h[4], h[5]); w.w = pk_bf16(h[6], h[7]);
                *(u32x4*)(O + (size_t)row * ldo + col0) = w;
            }
    }
};

struct EpiRes {
    static constexpr bool PERM = true, AFTER_DRAIN = false;
    bf16_t* XB; float* ss_out; float alpha;
    __device__ __forceinline__ void operator()(const f32x4 (&acc)[2][2][4][2], const pg8::Unit& u, int wr, int wc, int fr, int fq) const {
        const int row0 = u.pm * 256 + wr * 64 + fr, col0 = u.pn * 256 + wc * 32 + 8 * fq;
#pragma unroll
        for (int ai = 0; ai < 2; ++ai)
#pragma unroll
            for (int m = 0; m < 4; ++m) {
                const int row = row0 + ai * 128 + m * 16;
                float sq = 0.f;
#pragma unroll
                for (int bj = 0; bj < 2; ++bj) {
                    bf16_t* px = XB + (size_t)row * DM + col0 + bj * 128;
                    const u32x4 xo = *(const u32x4*)px;
                    u32x4 w;
#pragma unroll
                    for (int i = 0; i < 4; ++i) {
                        const float lo = __uint_as_float(xo[i] << 16) + acc[ai][bj][m][i >> 1][(i & 1) * 2] * alpha;
                        const float hi = __uint_as_float(xo[i] & 0xffff0000u) + acc[ai][bj][m][i >> 1][(i & 1) * 2 + 1] * alpha;
                        const unsigned pk = pk_bf16(lo, hi);
                        w[i] = pk;
                        const float rl = __uint_as_float(pk << 16), rh = __uint_as_float(pk & 0xffff0000u);
                        sq += rl * rl + rh * rh;
                    }
                    *(u32x4*)px = w;
                }
                sq += __shfl_xor(sq, 16); sq += __shfl_xor(sq, 32);
                if (fq == 0) ss_out[(size_t)row * 16 + u.pn * 4 + wc] = sq;
                asm volatile("" ::: "memory");
            }
    }
};

struct EpiRow {
    static constexpr bool PERM = true, AFTER_DRAIN = false;
    bf16_t* O; int ldo; int split_tiles; size_t split_stride;
    const float* ss; float inv_dim; int nsl;
    int gelu_from; int rope_pn, rope_bj, rope_wc;
    const float* cs; const float* sn;
    unsigned long long stat_map; float* stb;
    __device__ __forceinline__ void operator()(const f32x4 (&acc)[2][2][4][2], const pg8::Unit& u, int wr, int wc, int fr, int fq) const {
        const int row0 = u.pm * 256 + wr * 64 + fr;
        int colt = u.pn * 256; bf16_t* base = O;
        if (split_tiles && u.pn >= split_tiles) { base += split_stride; colt -= split_tiles * 256; }
        const bool do_gelu = u.pn >= gelu_from;
        f32x4 sp[2][4]; float rsv[2][4];
#pragma unroll
        for (int ai = 0; ai < 2; ++ai)
#pragma unroll
            for (int m = 0; m < 4; ++m) sp[ai][m] = row_ss_part(ss, row0 + ai * 128 + m * 16, nsl, fq);
#pragma unroll
        for (int ai = 0; ai < 2; ++ai)
#pragma unroll
            for (int m = 0; m < 4; ++m) rsv[ai][m] = rsqrtf(row_ss_fin(sp[ai][m]) * inv_dim + EPS);
#pragma unroll
        for (int bj = 0; bj < 2; ++bj) {
            const bool do_rope = (u.pn == rope_pn) && (rope_bj < 0 || (bj == rope_bj && wc == rope_wc));
            const int sidx = (int)((stat_map >> (4 * (u.pn * 2 + bj))) & 15ull);
            float* st = stb + (size_t)(sidx > 0 ? sidx - 1 : 0) * ((size_t)S * 16);
            const int sbase = (int)((0x0a0300u >> (8 * (sidx > 0 ? sidx - 1 : 0))) & 255u);
            const int col0 = colt + bj * 128 + wc * 32 + 8 * fq;
#pragma unroll
            for (int ai = 0; ai < 2; ++ai)
#pragma unroll
                for (int m = 0; m < 4; ++m) {
                    const int row = row0 + ai * 128 + m * 16;
                    const float rs = rsv[ai][m];
                    float v[8];
#pragma unroll
                    for (int n = 0; n < 2; ++n)
#pragma unroll
                        for (int j = 0; j < 4; ++j) v[n * 4 + j] = acc[ai][bj][m][n][j] * rs;
                    if (do_gelu) {
#pragma unroll
                        for (int i = 0; i < 8; i += 2) { const f32x2 g = pg8::gelu_pk((f32x2){v[i], v[i + 1]}); v[i] = g.x; v[i + 1] = g.y; }
                    }
                    if (do_rope) {
                        const f32x4 c0 = *(const f32x4*)(cs + (size_t)row * 16 + 8 * (fq & 1)), c1 = *(const f32x4*)(cs + (size_t)row * 16 + 8 * (fq & 1) + 4);
                        const f32x4 s0 = *(const f32x4*)(sn + (size_t)row * 16 + 8 * (fq & 1)), s1 = *(const f32x4*)(sn + (size_t)row * 16 + 8 * (fq & 1) + 4);
                        const float sg = (fq < 2) ? -1.f : 1.f;
#pragma unroll
                        for (int i = 0; i < 8; ++i) {
                            const float pt = __shfl_xor(v[i], 32);
                            const float cc = i < 4 ? c0[i & 3] : c1[i & 3], sv = i < 4 ? s0[i & 3] : s1[i & 3];
                            v[i] = v[i] * cc + sg * pt * sv;
                        }
                    }
                    if (sidx) {
                        float sq = 0.f;
#pragma unroll
                        for (int i = 0; i < 8; ++i) sq += v[i] * v[i];
                        sq += __shfl_xor(sq, 16); sq += __shfl_xor(sq, 32);
                        if (fq == 0) st[(size_t)row * 16 + (u.pn * 2 + bj - sbase) * 4 + wc] = sq;
                    }
                    u32x4 w; w.x = pk_bf16(v[0], v[1]); w.y = pk_bf16(v[2], v[3]); w.z = pk_bf16(v[4], v[5]); w.w = pk_bf16(v[6], v[7]);
                    *(u32x4*)(base + (size_t)row * ldo + col0) = w;
                }
        }
    }
};

struct Job { const float* W; int K, N; bf16_t* dst; const float* gain; int mode; float scale; };
enum { M_PLAIN = 0, M_GATE, M_UP, M_EVENIN, M_Q, M_KV, M_CONVIN };
constexpr float Q_SCALE = 0.10206207261596577f * 1.4426950408889634f;

__device__ __forceinline__ int job_items(int j) {
    if (j < 24) { const int t = j % 6; return (t == 2 || t == 5) ? 44 * 32 : 16 * 88; }
    if (j < 32) { const int t = (j - 24) & 3; return t == 0 ? 16 * 53 : (t == 1 ? 6 * 24 : (t == 2 ? 4 * 32 : 16 * 32)); }
    return ((j - 32) & 1) ? 16 * 32 : 16 * 96;
}
__device__ __forceinline__ Job get_job(const Params& p, int j) {
    Job b; b.scale = 1.f; b.gain = nullptr; b.mode = M_PLAIN;
    unsigned char* ws = p.ws;
    if (j < 24) {
        const int l = j / 6, t = j % 6, post = t >= 3, tt = t % 3;
        const float* nrm = p.in[post ? 7 : 2] + l * DM;
        const float* wg = p.in[post ? 8 : 3] + (size_t)l * DM * FF;
        const float* wu = p.in[post ? 9 : 4] + (size_t)l * DM * FF;
        const float* wd = p.in[post ? 10 : 5] + (size_t)l * DM * FF;
        if (tt == 0) { b.W = wg; b.K = DM; b.N = FF; b.dst = (bf16_t*)(ws + OFF_WGU) + (size_t)(2 * l + post) * NGU * DM; b.gain = nrm; b.mode = M_GATE; }
        else if (tt == 1) { b.W = wu; b.K = DM; b.N = FF; b.dst = (bf16_t*)(ws + OFF_WGU) + (size_t)(2 * l + post) * NGU * DM; b.gain = nrm; b.mode = M_UP; }
        else { b.W = wd; b.K = FF; b.N = DM; b.dst = (bf16_t*)(ws + OFF_WD) + (size_t)(2 * l + post) * DM * FF; }
    } else if (j < 32) {
        const int e = (j - 24) >> 2, t = (j - 24) & 3;
        if (t == 0) { b.W = p.in[11] + (size_t)e * DM * 1696; b.K = DM; b.N = 1696; b.dst = (bf16_t*)(ws + OFF_WIN) + (size_t)e * PW * DM; b.gain = p.in[6] + (2 * e) * DM; b.mode = M_EVENIN; }
        else if (t == 1) { b.W = p.in[13] + (size_t)e * 384 * 768; b.K = 384; b.N = 768; b.dst = (bf16_t*)(ws + OFF_WUQ) + (size_t)e * 768 * 384; b.gain = p.in[12] + e * 384; b.mode = M_Q; b.scale = Q_SCALE; }
        else if (t == 2) { b.W = p.in[15] + (size_t)e * 256 * 1024; b.K = 256; b.N = 1024; b.dst = (bf16_t*)(ws + OFF_WUKV) + (size_t)e * 1024 * 256; b.gain = p.in[14] + e * 256; b.mode = M_KV; }
        else { b.W = p.in[19] + (size_t)e * DM * DM; b.K = DM; b.N = DM; b.dst = (bf16_t*)(ws + OFF_WOUT) + (size_t)e * DM * DM; }
    } else {
        const int o = (j - 32) >> 1, t = (j - 32) & 1;
        if (t == 0) { b.W = p.in[20] + (size_t)o * DM * 3072; b.K = DM; b.N = 3072; b.dst = (bf16_t*)(ws + OFF_WCIN) + (size_t)o * 3072 * DM; b.gain = p.in[6] + (2 * o + 1) * DM; b.mode = M_CONVIN; }
        else { b.W = p.in[22] + (size_t)o * DM * DM; b.K = DM; b.N = DM; b.dst = (bf16_t*)(ws + OFF_WCOUT) + (size_t)o * DM * DM; }
    }
    return b;
}
__device__ __forceinline__ int map_row(int mode, int n) {
    switch (mode) {
        case M_GATE: return 256 * (n >> 7) + (n & 127);
        case M_UP: return 256 * (n >> 7) + 128 + (n & 127);
        case M_EVENIN: return n < 672 ? n : n + 96;
        case M_Q: { const int hd = n / 96, d = n - hd * 96; return d < 64 ? hd * 64 + d : 512 + hd * 32 + (d - 64); }
        case M_KV: { const int hd = n >> 7, d = n & 127; return d < 64 ? hd * 64 + d : 512 + hd * 64 + (d - 64); }
        case M_CONVIN: { if (n < 1024) return 2048 + n; if (n < 2048) { const int jn = n - 1024; return 256 * (jn >> 7) + (jn & 127); } const int jn = n - 2048; return 256 * (jn >> 7) + 128 + (jn & 127); }
        default: return n;
    }
}
__device__ __forceinline__ void transpose_item(const Job& jb, LAS float* scr, int item, int lane) {
    const int nblk = jb.N / 32, kb = item / nblk, nb = item - kb * nblk, k0 = 64 * kb, n0 = 32 * nb;
    const int kr = lane >> 3, c4 = (lane & 7) * 4;
    f32x4 v[8]; float gk[8];
#pragma unroll
    for (int i = 0; i < 8; ++i) {
        const int kk = 8 * i + kr;
        v[i] = *(const f32x4*)(jb.W + (size_t)(k0 + kk) * jb.N + n0 + c4);
        gk[i] = (jb.gain ? jb.gain[k0 + kk] : 1.0f) * jb.scale;
    }
#pragma unroll
    for (int i = 0; i < 8; ++i) {
        const int kk = 8 * i + kr;
        LAS float* d = scr + kk * 33 + c4;
        d[0] = v[i][0] * gk[i]; d[1] = v[i][1] * gk[i]; d[2] = v[i][2] * gk[i]; d[3] = v[i][3] * gk[i];
    }
    asm volatile("s_waitcnt lgkmcnt(0)" ::: "memory");
    const int c = lane & 7, r0 = map_row(jb.mode, n0);
#pragma unroll
    for (int j = 0; j < 4; ++j) {
        const int n = (lane >> 3) + 8 * j; const LAS float* s = scr + (8 * c) * 33 + n;
        u32x4 o; o.x = pk_bf16(s[0 * 33], s[1 * 33]); o.y = pk_bf16(s[2 * 33], s[3 * 33]); o.z = pk_bf16(s[4 * 33], s[5 * 33]); o.w = pk_bf16(s[6 * 33], s[7 * 33]);
        *(u32x4*)(jb.dst + (size_t)(r0 + n) * jb.K + k0 + 8 * c) = o;
    }
    asm volatile("s_waitcnt lgkmcnt(0)" ::: "memory");
}

__device__ __forceinline__ void convert_jobs(const Params& p, LAS unsigned char* lds, int j_lo, int j_hi, int w, int nw, int lane, int wave) {
    LAS float* scr = (LAS float*)(lds + wave * 8704);
    int total = 0;
    for (int j = j_lo; j < j_hi; ++j) total += job_items(j);
    for (int it = w; it < total; it += nw) {
        int r = it, j = j_lo;
        for (; j < j_hi; ++j) { const int c = job_items(j); if (r < c) break; r -= c; }
        const Job jb = get_job(p, j);
        transpose_item(jb, scr, r, lane);
    }
}
__device__ __forceinline__ void prologue(const Params& p, LAS unsigned char* lds, int gw, int ngw, int lane, int wave) {
    unsigned char* ws = p.ws;
    {
        float* cs = (float*)(ws + OFF_ROPE); float* sn = cs + S * 16;
        const int* pos = (const int*)p.in[1];
        for (int idx = gw * 64 + lane; idx < S * 16; idx += ngw * 64) {
            const int t = idx >> 4, i = idx & 15;
            const float ang = (float)pos[t] * p.inv_freq[i];
            const double a = (double)ang;
            const double k = rint(a * 0.15915494309189535);
            const double r = a - k * 6.283185307179586;
            const double r2 = r * r;
            double ts = r, ssum = r, tc = 1.0, csum = 1.0;
#pragma unroll 1
            for (int q = 1; q <= 15; ++q) {
                tc *= -r2 / (double)((2 * q - 1) * (2 * q)); csum += tc;
                ts *= -r2 / (double)((2 * q) * (2 * q + 1)); ssum += ts;
            }
            cs[idx] = (float)csum; sn[idx] = (float)ssum;
        }
    }
    {
        const float* x = p.in[0]; bf16_t* XB = (bf16_t*)(ws + OFF_XB); float* ss0 = (float*)(ws + OFF_SS);
        for (int row = gw; row < S; row += ngw) {
            const f32x4* xr = (const f32x4*)(x + (size_t)row * DM) + lane;
            float s = 0.f;
#pragma unroll
            for (int j = 0; j < 4; ++j) {
                const f32x4 v = xr[64 * j];
                u32x2 w; w.x = pk_bf16(v[0], v[1]); w.y = pk_bf16(v[2], v[3]);
                ((u32x2*)(XB + (size_t)row * DM) + lane)[64 * j] = w;
                const float a = __uint_as_float(w.x << 16), b = __uint_as_float(w.x & 0xffff0000u), c = __uint_as_float(w.y << 16), d = __uint_as_float(w.y & 0xffff0000u);
                s += (a * a + b * b) + (c * c + d * d);
            }
#pragma unroll
            for (int o = 1; o < 64; o <<= 1) s += __shfl_xor(s, o);
            if (lane < 16) ss0[(size_t)row * 16 + lane] = (lane == 0) ? s : 0.f;
        }
    }
    for (int e = 0; e < 2; ++e) {
        u32x4* z = (u32x4*)((bf16_t*)(ws + OFF_WIN) + (size_t)e * PW * DM + (size_t)672 * DM);
        for (int idx = gw * 64 + lane; idx < 96 * DM / 8; idx += ngw * 64) z[idx] = (u32x4){0u, 0u, 0u, 0u};
    }
    convert_jobs(p, lds, 0, 3, gw, ngw, lane, wave);
}

__device__ __forceinline__ void sgu_unit(LAS unsigned char* lds, int unit, const bf16_t* __restrict__ P, const float* __restrict__ ssv,
                                         const float* __restrict__ sgw, const float* __restrict__ sgb, const float* __restrict__ sgn, bf16_t* __restrict__ MIX) {
    int tid_l = threadIdx.x; asm volatile("" : "+v"(tid_l)); const int tid = tid_l, lane = tid & 63, wid = __builtin_amdgcn_readfirstlane(tid >> 6), r32 = lane & 31, hi = lane >> 5;
    const int chunk = unit >> 1, hf = unit & 1, s0 = chunk * 128;
    LAS float* rv = (LAS float*)lds;
    LAS unsigned short* vT = (LAS unsigned short*)(lds + 1024);
    if (tid < 128) rv[tid] = rsqrtf(row_ss(ssv, s0 + tid, 16) * (1.0f / 512.0f) + EPS);
#pragma unroll
    for (int i = 0; i < 8; ++i) {
        const int c = tid + 512 * i, srow = c >> 5, part = c & 31;
        const u32x4 d = *(const u32x4*)(P + (size_t)(s0 + srow) * PW + P_V + hf * 256 + part * 8);
        LAS unsigned short* dst = vT + (size_t)(part * 8) * 136 + srow;
        dst[0 * 136] = (unsigned short)(d.x & 0xffffu); dst[1 * 136] = (unsigned short)(d.x >> 16);
        dst[2 * 136] = (unsigned short)(d.y & 0xffffu); dst[3 * 136] = (unsigned short)(d.y >> 16);
        dst[4 * 136] = (unsigned short)(d.z & 0xffffu); dst[5 * 136] = (unsigned short)(d.z >> 16);
        dst[6 * 136] = (unsigned short)(d.w & 0xffffu); dst[7 * 136] = (unsigned short)(d.w >> 16);
    }
    __syncthreads();
    const int gl = wid & 3, rh = wid >> 2, g = 4 * hf + gl;
    f32x16 acc[2][2];
#pragma unroll
    for (int a = 0; a < 2; ++a)
#pragma unroll
        for (int b = 0; b < 2; ++b)
#pragma unroll
            for (int r = 0; r < 16; ++r) acc[a][b][r] = 0.f;
#pragma unroll
    for (int mt = 0; mt < 2; ++mt) {
        const int T0 = 64 * rh + 32 * mt, nks = (T0 + 32) >> 4, t = T0 + r32;
        for (int ks = 0; ks < nks; ++ks) {
            const int sb = 16 * ks + 8 * hi;
            const float* wp = sgw + ((size_t)g * 128 + t) * 128 + sb;
            const f32x4 w0 = *(const f32x4*)wp, w1 = *(const f32x4*)(wp + 4);
            const f32x4 q0 = *(const LAS f32x4*)(rv + sb), q1 = *(const LAS f32x4*)(rv + sb + 4);
            float a[8];
#pragma unroll
            for (int j = 0; j < 4; ++j) { a[j] = (sb + j <= t) ? w0[j] * q0[j] : 0.f; a[4 + j] = (sb + 4 + j <= t) ? w1[j] * q1[j] : 0.f; }
            u32x4 aw; aw.x = pk_bf16(a[0], a[1]); aw.y = pk_bf16(a[2], a[3]); aw.z = pk_bf16(a[4], a[5]); aw.w = pk_bf16(a[6], a[7]);
            const bf16x8 af = __builtin_bit_cast(bf16x8, aw);
#pragma unroll
            for (int nt = 0; nt < 2; ++nt) {
                const bf16x8 bfr = *(const LAS bf16x8*)(vT + (size_t)(gl * 64 + 32 * nt + r32) * 136 + sb);
                acc[mt][nt] = __builtin_amdgcn_mfma_f32_32x32x16_bf16(bfr, af, acc[mt][nt], 0, 0, 0);
            }
        }
    }
#pragma unroll
    for (int mt = 0; mt < 2; ++mt) {
        const int tt = 64 * rh + 32 * mt + r32;
        const float bias = sgb[g * 128 + tt];
#pragma unroll
        for (int nt = 0; nt < 2; ++nt)
#pragma unroll
            for (int rg = 0; rg < 4; ++rg) {
                const int col = g * 64 + 32 * nt + 8 * rg + 4 * hi;
                const f32x4 gn = *(const f32x4*)(sgn + col);
                const u32x2 uu = *(const u32x2*)(P + (size_t)(s0 + tt) * PW + P_U + col);
                const float o0 = __uint_as_float(uu.x << 16) * (gn[0] * acc[mt][nt][4 * rg + 0] + bias);
                const float o1 = __uint_as_float(uu.x & 0xffff0000u) * (gn[1] * acc[mt][nt][4 * rg + 1] + bias);
                const float o2 = __uint_as_float(uu.y << 16) * (gn[2] * acc[mt][nt][4 * rg + 2] + bias);
                const float o3 = __uint_as_float(uu.y & 0xffff0000u) * (gn[3] * acc[mt][nt][4 * rg + 3] + bias);
                u32x2 w; w.x = pk_bf16(o0, o1); w.y = pk_bf16(o2, o3);
                *(u32x2*)(MIX + (size_t)(s0 + tt) * DM + 512 + col) = w;
            }
    }
    __syncthreads();
}

constexpr int AT_KSTR = 208, AT_VSTR = 192, AT_KB = 64 * AT_KSTR, AT_VB = 64 * AT_VSTR;
constexpr float ATT_THR = 8.0f;
#define MX3(a, b, c) __builtin_fmaxf(__builtin_fmaxf((a), (b)), (c))
typedef __bf16 bf16x2_t __attribute__((ext_vector_type(2)));
__device__ __forceinline__ unsigned pk2(float lo, float hi) { f32x2 v = {lo, hi}; bf16x2_t b = __builtin_convertvector(v, bf16x2_t); return __builtin_bit_cast(unsigned, b); }
__device__ __forceinline__ float rowmax32(const f32x16& a, const f32x16& b) {
    float x = MX3(a[0], a[1], b[0]), y = MX3(a[2], a[3], b[1]); x = MX3(x, b[2], b[3]);
#pragma unroll
    for (int r = 4; r < 16; r += 4) { x = MX3(x, a[r], a[r + 1]); y = MX3(y, a[r + 2], a[r + 3]); x = MX3(x, b[r], b[r + 1]); y = MX3(y, b[r + 2], b[r + 3]); }
    return swap32_max(__builtin_fmaxf(x, y));
}
__device__ __forceinline__ void attn_kload(bf16x8 (&kf)[12], const LAS unsigned char* Ks, int r32, int hi) {
#pragma unroll
    for (int d0 = 0; d0 < 6; ++d0) {
        kf[2 * d0] = *(const LAS bf16x8*)(Ks + r32 * AT_KSTR + d0 * 32 + hi * 16);
        kf[2 * d0 + 1] = *(const LAS bf16x8*)(Ks + (32 + r32) * AT_KSTR + d0 * 32 + hi * 16);
    }
}
__device__ __forceinline__ void attn_qk(f32x16& s0, f32x16& s1, const bf16x8 (&kf)[12], const bf16x8 (&qf)[6], const f32x16& negm) {
#pragma unroll
    for (int d0 = 0; d0 < 6; ++d0) {
        if (d0 == 0) { s0 = __builtin_amdgcn_mfma_f32_32x32x16_bf16(kf[0], qf[0], negm, 0, 0, 0); s1 = __builtin_amdgcn_mfma_f32_32x32x16_bf16(kf[1], qf[0], negm, 0, 0, 0); }
        else { s0 = __builtin_amdgcn_mfma_f32_32x32x16_bf16(kf[2 * d0], qf[d0], s0, 0, 0, 0); s1 = __builtin_amdgcn_mfma_f32_32x32x16_bf16(kf[2 * d0 + 1], qf[d0], s1, 0, 0, 0); }
    }
}
__device__ __forceinline__ void attn_mask(f32x16& s0, f32x16& s1, int jb, int qrel, int hi) {
#pragma unroll
    for (int r = 0; r < 16; ++r) {
        const int kv = 64 * jb + crow(r, hi);
        if (kv > qrel) s0[r] = -INFINITY;
        if (kv + 32 > qrel) s1[r] = -INFINITY;
    }
}
__device__ __forceinline__ void attn_unit(LAS unsigned char* lds, const bf16_t* __restrict__ Qb, const bf16_t* __restrict__ KN, const bf16_t* __restrict__ Pb,
                                          const bf16_t* __restrict__ Vb, bf16_t* __restrict__ MIX, int h, int qb) {
    int tid_l = threadIdx.x; asm volatile("" : "+v"(tid_l)); const int tid = tid_l, lane = tid & 63, wid = __builtin_amdgcn_readfirstlane(tid >> 6), r32 = lane & 31, hi = lane >> 5;
    const int qrow = qb * 256 + wid * 32 + r32, qrel = 32 * wid + r32;
    bf16x8 qf[6];
    {
        const bf16_t* qp = Qb + (size_t)qrow * QW;
#pragma unroll
        for (int d0 = 0; d0 < 4; ++d0) qf[d0] = *(const bf16x8*)(qp + h * 64 + d0 * 16 + hi * 8);
#pragma unroll
        for (int d0 = 4; d0 < 6; ++d0) qf[d0] = *(const bf16x8*)(qp + 512 + h * 32 + (d0 - 4) * 16 + hi * 8);
    }
    const int NT = 4 * qb + 4;
    const int ra = tid / 12, pa = tid - ra * 12;
    const int cb = 512 + tid, rb = cb / 12, pb = cb - rb * 12;
    const bf16_t* srcA = pa < 8 ? KN + (size_t)ra * 512 + h * 64 + pa * 8 : Pb + (size_t)ra * PW + P_KR + (pa - 8) * 8;
    const size_t strA = pa < 8 ? (size_t)64 * 512 : (size_t)64 * PW;
    const bf16_t* srcB = pb < 8 ? KN + (size_t)rb * 512 + h * 64 + pb * 8 : Pb + (size_t)rb * PW + P_KR + (pb - 8) * 8;
    const size_t strB = pb < 8 ? (size_t)64 * 512 : (size_t)64 * PW;
    const bf16_t* srcV = Vb + (size_t)(tid >> 3) * 512 + h * 64 + (tid & 7) * 8;
    const int dstA = ra * AT_KSTR + pa * 16, dstB = rb * AT_KSTR + pb * 16, dstV = 4 * AT_KB + (tid >> 3) * AT_VSTR + (tid & 7) * 16;
    const bool hasB = tid < 256;
    u32x4 ga, gb = (u32x4){0u, 0u, 0u, 0u}, gv, ha, hb = (u32x4){0u, 0u, 0u, 0u}, hv;
    {
        const u32x4 k0a = *(const u32x4*)srcA, k1a = *(const u32x4*)(srcA + strA), k2a = *(const u32x4*)(srcA + 2 * strA);
        const u32x4 v0 = *(const u32x4*)srcV, v1 = *(const u32x4*)(srcV + (size_t)64 * 512);
        u32x4 k0b = gb, k1b = gb, k2b = gb;
        if (hasB) { k0b = *(const u32x4*)srcB; k1b = *(const u32x4*)(srcB + strB); k2b = *(const u32x4*)(srcB + 2 * strB); }
        *(LAS u32x4*)(lds + dstA) = k0a; *(LAS u32x4*)(lds + AT_KB + dstA) = k1a; *(LAS u32x4*)(lds + 2 * AT_KB + dstA) = k2a;
        *(LAS u32x4*)(lds + dstV) = v0; *(LAS u32x4*)(lds + AT_VB + dstV) = v1;
        if (hasB) { *(LAS u32x4*)(lds + dstB) = k0b; *(LAS u32x4*)(lds + AT_KB + dstB) = k1b; *(LAS u32x4*)(lds + 2 * AT_KB + dstB) = k2b; }
    }
    __syncthreads();
    float mref = 0.f, lrun = 0.f, mxc;
    f32x16 o0, o1, negm, sA0, sA1, sB0, sB1;
#pragma unroll
    for (int r = 0; r < 16; ++r) { o0[r] = 0.f; o1[r] = 0.f; negm[r] = 0.f; }
    const int i16 = lane & 15, vq = i16 >> 2, vp = i16 & 3, vblk = (lane >> 4) & 1;
    const int voff = 4 * AT_KB + (4 * hi + vq) * AT_VSTR + vblk * 32 + vp * 8;
    { bf16x8 kf0[12]; attn_kload(kf0, lds, r32, hi); attn_qk(sA0, sA1, kf0, qf, negm); }
    if (qb == 0) attn_mask(sA0, sA1, 0, qrel, hi);
    mref = rowmax32(sA0, sA1);
#pragma unroll
    for (int r = 0; r < 16; ++r) { sA0[r] -= mref; sA1[r] -= mref; negm[r] = -mref; }
    mxc = 0.f;
    __syncthreads();
#define ATT_STEP(C0, C1, N0, N1, T) do { \
        const int t_ = (T); \
        if (__any(mxc > ATT_THR)) { \
            const float dl = fmaxf(mxc, 0.f); mref += dl; const float al = __builtin_amdgcn_exp2f(-dl); lrun *= al; \
            _Pragma("unroll") for (int r = 0; r < 16; ++r) { C0[r] -= dl; C1[r] -= dl; negm[r] = -mref; o0[r] *= al; o1[r] *= al; } \
        } \
        const LAS unsigned char* Kn = lds + ((t_ + 1) & 3) * AT_KB; \
        bf16x8 kf[12]; attn_kload(kf, Kn, r32, hi); \
        __builtin_amdgcn_sched_barrier(0); \
        attn_qk(N0, N1, kf, qf, negm); \
        float ps0 = 0.f, ps1 = 0.f, ps2 = 0.f, ps3 = 0.f; \
        _Pragma("unroll") for (int r = 0; r < 16; r += 2) { C0[r] = __builtin_amdgcn_exp2f(C0[r]); C1[r] = __builtin_amdgcn_exp2f(C1[r]); C0[r + 1] = __builtin_amdgcn_exp2f(C0[r + 1]); C1[r + 1] = __builtin_amdgcn_exp2f(C1[r + 1]); \
            ps0 += C0[r]; ps1 += C1[r]; ps2 += C0[r + 1]; ps3 += C1[r + 1]; } \
        lrun += (ps0 + ps1) + (ps2 + ps3); \
        bf16x8 pf[4]; \
        _Pragma("unroll") for (int ks = 0; ks < 2; ++ks) { \
            u32x4 w0, w1; \
            w0.x = pk2(C0[8 * ks + 0], C0[8 * ks + 1]); w0.y = pk2(C0[8 * ks + 2], C0[8 * ks + 3]); w0.z = pk2(C0[8 * ks + 4], C0[8 * ks + 5]); w0.w = pk2(C0[8 * ks + 6], C0[8 * ks + 7]); \
            w1.x = pk2(C1[8 * ks + 0], C1[8 * ks + 1]); w1.y = pk2(C1[8 * ks + 2], C1[8 * ks + 3]); w1.z = pk2(C1[8 * ks + 4], C1[8 * ks + 5]); w1.w = pk2(C1[8 * ks + 6], C1[8 * ks + 7]); \
            asm volatile("" : "+v"(w0), "+v"(w1)); \
            pf[ks] = __builtin_bit_cast(bf16x8, w0); pf[2 + ks] = __builtin_bit_cast(bf16x8, w1); } \
        asm volatile("" : "+v"(lrun)); \
        _Pragma("unroll") for (int i_ = 0; i_ < 12; ++i_) { __builtin_amdgcn_sched_group_barrier(0x008, 1, 0); __builtin_amdgcn_sched_group_barrier(0x002, 7, 0); } \
        __builtin_amdgcn_sched_barrier(0); \
        const LAS unsigned char* Vs = lds + voff + (t_ & 3) * AT_VB; \
        s16x4 vlo[8], vhi[8]; \
        _Pragma("unroll") for (int ks = 0; ks < 4; ++ks) { \
            _Pragma("unroll") for (int db = 0; db < 2; ++db) { \
                const LAS unsigned char* vp0 = Vs + ks * 16 * AT_VSTR + db * 64; \
                vlo[ks * 2 + db] = __builtin_bit_cast(s16x4, __builtin_amdgcn_ds_read_tr16_b64_v4i16((LAS s16x4*)vp0)); \
                vhi[ks * 2 + db] = __builtin_bit_cast(s16x4, __builtin_amdgcn_ds_read_tr16_b64_v4i16((LAS s16x4*)(vp0 + 8 * AT_VSTR))); } } \
        if (t_ + 1 >= 4 * qb) attn_mask(N0, N1, t_ + 1 - 4 * qb, qrel, hi); \
        __builtin_amdgcn_sched_barrier(0); \
        _Pragma("unroll") for (int ks = 0; ks < 4; ++ks) { \
            _Pragma("unroll") for (int db = 0; db < 2; ++db) { \
                const s16x4 lo = vlo[ks * 2 + db], hh = vhi[ks * 2 + db]; \
                const bf16x8 vf = (bf16x8){lo[0], lo[1], lo[2], lo[3], hh[0], hh[1], hh[2], hh[3]}; \
                if (db == 0) o0 = __builtin_amdgcn_mfma_f32_32x32x16_bf16(vf, pf[ks], o0, 0, 0, 0); \
                else o1 = __builtin_amdgcn_mfma_f32_32x32x16_bf16(vf, pf[ks], o1, 0, 0, 0); } } \
        mxc = rowmax32(N0, N1); \
        _Pragma("unroll") for (int i_ = 0; i_ < 8; ++i_) { __builtin_amdgcn_sched_group_barrier(0x008, 1, 1); __builtin_amdgcn_sched_group_barrier(0x002, 3, 1); } \
        __builtin_amdgcn_sched_barrier(0); \
    } while (0)
    for (int t = 0; t < NT; t += 2) {
        const bool m3 = (t + 3 < NT), m4 = (t + 4 < NT), v2 = (t + 2 < NT);
        if (m3) { ga = *(const u32x4*)(srcA + (size_t)(t + 3) * strA); if (hasB) gb = *(const u32x4*)(srcB + (size_t)(t + 3) * strB); hv = *(const u32x4*)(srcV + (size_t)(t + 3) * 64 * 512); }
        if (m4) { ha = *(const u32x4*)(srcA + (size_t)(t + 4) * strA); if (hasB) hb = *(const u32x4*)(srcB + (size_t)(t + 4) * strB); }
        if (v2) gv = *(const u32x4*)(srcV + (size_t)(t + 2) * 64 * 512);
        ATT_STEP(sA0, sA1, sB0, sB1, t);
        ATT_STEP(sB0, sB1, sA0, sA1, t + 1);
        if (m3) { LAS unsigned char* kd = lds + ((t + 3) & 3) * AT_KB; *(LAS u32x4*)(kd + dstA) = ga; if (hasB) *(LAS u32x4*)(kd + dstB) = gb; *(LAS u32x4*)(lds + ((t + 3) & 3) * AT_VB + dstV) = hv; }
        if (m4) { LAS unsigned char* kd = lds + ((t + 4) & 3) * AT_KB; *(LAS u32x4*)(kd + dstA) = ha; if (hasB) *(LAS u32x4*)(kd + dstB) = hb; }
        if (v2) *(LAS u32x4*)(lds + ((t + 2) & 3) * AT_VB + dstV) = gv;
        __syncthreads();
    }
#undef ATT_STEP
    const float inv = 1.0f / swap32_sum(lrun);
    bf16_t* op = MIX + (size_t)qrow * DM + h * 64 + 4 * hi;
#pragma unroll
    for (int rg = 0; rg < 4; ++rg) {
        u32x2 w0, w1;
        w0.x = pk_bf16(o0[4 * rg] * inv, o0[4 * rg + 1] * inv); w0.y = pk_bf16(o0[4 * rg + 2] * inv, o0[4 * rg + 3] * inv);
        w1.x = pk_bf16(o1[4 * rg] * inv, o1[4 * rg + 1] * inv); w1.y = pk_bf16(o1[4 * rg + 2] * inv, o1[4 * rg + 3] * inv);
        *(u32x2*)(op + 8 * rg) = w0; *(u32x2*)(op + 32 + 8 * rg) = w1;
    }
}

__global__ void __launch_bounds__(NTHREADS, 2) mega_fwd(Params p) {
    extern __shared__ __attribute__((aligned(16))) unsigned char lds_raw[];
    LAS unsigned char* lds = (LAS unsigned char*)lds_raw;
    cg::grid_group grid = cg::this_grid();
    const int G = gridDim.x, bid = blockIdx.x;
    const int ngw = G * NWAVES;
#define LAUNDER_TID() int tid_l = threadIdx.x; asm volatile("" : "+v"(tid_l)); const int tid = tid_l, lane = tid & 63, wave = __builtin_amdgcn_readfirstlane(tid >> 6), gw = bid * NWAVES + wave; (void)tid; (void)lane; (void)gw;
    unsigned char* ws = p.ws;
    float* ssb = (float*)(ws + OFF_SS);
    bf16_t* XB = (bf16_t*)(ws + OFF_XB);
    const float* cs = (const float*)(ws + OFF_ROPE); const float* sn = cs + S * 16;
    int st = 0;
    const int lo = p.step_lo, hi_ = p.step_hi;
    const bool single = (lo == 0 && hi_ >= 1000);
#define RUN (st >= lo && st < hi_)
#define SYNC() do { if (single) xcd_barrier(xbar); ++st; } while (0)

    volatile LAS unsigned* xst = (volatile LAS unsigned*)(lds + LDS_MISC);
    if (threadIdx.x < 2) xst[threadIdx.x] = 0u;
    __syncthreads();
    XcdBarrier xbar; xbar.bar = (unsigned*)(ws + OFF_BAR); xbar.x = 0; xbar.st = xst;
    if (single) xbar = xcd_barrier_post((unsigned*)(ws + OFF_BAR), xst);
    if (p.step_hi < 0) grid.sync();
    if (RUN) { LAUNDER_TID(); prologue(p, lds, gw, ngw, lane, wave); }
    if (single) xcd_barrier(xbar);
    ++st;

    for (int l = 0; l < 4; ++l) {
        for (int sub = 0; sub < 3; ++sub) {
            const bool is_ffn = (sub != 1), even = ((l & 1) == 0);
            const int e = l >> 1;
            const int kin = l * 3 + sub;
            float* ss_in = ssb + (size_t)kin * S * 16; float* ss_out = ssb + (size_t)(kin + 1) * S * 16;
            float* ss_cq = ssb + (size_t)(13 + 3 * e) * S * 16; float* ss_ckv = ss_cq + (size_t)S * 16; float* ss_v = ss_ckv + (size_t)S * 16;
            if (is_ffn || !even) {
                if (RUN) {
                    pg8::Gemm g; pg8::StaticOrder So; EpiPair E;
                    g.A = XB; g.M = S; g.K = DM; g.lda = DM; g.ldb = DM;
                    if (is_ffn) { g.Bt = (const bf16_t*)(ws + OFF_WGU) + (size_t)(2 * l + (sub == 2)) * NGU * DM; g.N = NGU; E.O = (bf16_t*)(ws + OFF_ACT); E.ldo = FF; E.mode = 0; }
                    else { g.Bt = (const bf16_t*)(ws + OFF_WCIN) + (size_t)e * 3072 * DM; g.N = 2048; E.O = (bf16_t*)(ws + OFF_CZ); E.ldo = DM; E.mode = 1; }
                    E.ss = ss_in; E.inv_dim = 1.0f / DM;
                    So.init(S, g.N, G, bid);
                    pg8::gemm_phase<EpiPair, pg8::StaticOrder, true, true>(lds, g, So, E);
                    if (is_ffn) {
                        const int nfull = (64 * 22) % G, nwk = nfull ? G - nfull : G, wk = nfull ? bid - nfull : bid;
                        if (wk >= 0) {
                            LAUNDER_TID();
                            int a0, a1, b0 = 0, b1 = 0;
                            if (sub == 0) { a0 = 6 * l + 3; a1 = 6 * l + 6; if (l == 0) { b0 = 24; b1 = 28; } }
                            else if (l < 3) { const int ln = l + 1; a0 = 6 * ln; a1 = 6 * ln + 3; if (ln & 1) { b0 = 32 + 2 * (ln >> 1); b1 = b0 + 2; } else { b0 = 24 + 4 * (ln >> 1); b1 = b0 + 4; } }
                            else { a0 = 0; a1 = 0; }
                            convert_jobs(p, lds, a0, a1, wk * NWAVES + wave, nwk * NWAVES, lane, wave);
                            convert_jobs(p, lds, b0, b1, wk * NWAVES + wave, nwk * NWAVES, lane, wave);
                        }
                    }
                }
            }
            if (!is_ffn) {
                const int ng = even ? 3 : 1;
                for (int gi = 0; gi < ng; ++gi) {
                    if (RUN) {
                        pg8::Gemm g; pg8::StaticOrder So; EpiRow E;
                        g.M = S; E.split_tiles = 0; E.split_stride = 0; E.gelu_from = 1 << 20; E.rope_pn = -1; E.rope_bj = -1; E.rope_wc = 0; E.cs = cs; E.sn = sn;
                        E.stat_map = 0ull; E.stb = ss_cq;
                        if (!even) {
                            g.A = XB; g.lda = DM; g.K = DM; g.ldb = DM; g.Bt = (const bf16_t*)(ws + OFF_WCIN) + (size_t)e * 3072 * DM + (size_t)2048 * DM; g.N = 1024;
                            E.O = (bf16_t*)(ws + OFF_BG); E.ldo = DM; E.ss = ss_in; E.inv_dim = 1.0f / DM; E.nsl = 16;
                        } else if (gi == 0) {
                            g.A = XB; g.lda = DM; g.K = DM; g.ldb = DM; g.Bt = (const bf16_t*)(ws + OFF_WIN) + (size_t)e * PW * DM; g.N = PW;
                            E.O = (bf16_t*)(ws + OFF_P); E.ldo = PW; E.ss = ss_in; E.inv_dim = 1.0f / DM; E.nsl = 16;
                            E.gelu_from = 3; E.rope_pn = 2; E.rope_bj = 1; E.rope_wc = 0;
                            E.stat_map = 0x1ull | (0x1ull << 4) | (0x1ull << 8) | (0x2ull << 12) | (0x2ull << 16) | (0x3ull << 40) | (0x3ull << 44) | (0x3ull << 48) | (0x3ull << 52);
                        } else if (gi == 1) {
                            g.A = (const bf16_t*)(ws + OFF_P) + P_CKV; g.lda = PW; g.K = 256; g.ldb = 256; g.Bt = (const bf16_t*)(ws + OFF_WUKV) + (size_t)e * 1024 * 256; g.N = 1024;
                            E.O = (bf16_t*)(ws + OFF_KN); E.ldo = 512; E.split_tiles = 2; E.split_stride = (OFF_V - OFF_KN) / 2; E.ss = ss_ckv; E.inv_dim = 1.0f / 256.0f; E.nsl = 8;
                        } else {
                            g.A = (const bf16_t*)(ws + OFF_P) + P_CQ; g.lda = PW; g.K = 384; g.ldb = 384; g.Bt = (const bf16_t*)(ws + OFF_WUQ) + (size_t)e * 768 * 384; g.N = 768;
                            E.O = (bf16_t*)(ws + OFF_Q); E.ldo = QW; E.ss = ss_cq; E.inv_dim = 1.0f / 384.0f; E.nsl = 12; E.rope_pn = 2; E.rope_bj = -1;
                        }
                        So.init(S, g.N, G, bid);
                        pg8::gemm_phase<EpiRow, pg8::StaticOrder, true, true>(lds, g, So, E);
                    }
                    if (even && gi == 0) SYNC();
                }
            }
            SYNC();
            if (!is_ffn) {
                if (RUN) {
                    if (even) {
                        const bf16_t* P = (const bf16_t*)(ws + OFF_P);
                        bf16_t* MIX = (bf16_t*)(ws + OFF_MIX);
                        for (int u = bid; u < 256; u += G)
                            sgu_unit(lds, u, P, ss_v, p.in[17] + (size_t)e * 8 * 128 * 128, p.in[18] + (size_t)e * 8 * 128, p.in[16] + (size_t)e * 512, MIX);
                        for (int u = bid; u < 256; u += G) {
                            const int h = u & 7, s = u >> 3;
                            attn_unit(lds, (const bf16_t*)(ws + OFF_Q), (const bf16_t*)(ws + OFF_KN), P, (const bf16_t*)(ws + OFF_V), MIX, h, 63 - s);
                            attn_unit(lds, (const bf16_t*)(ws + OFF_Q), (const bf16_t*)(ws + OFF_KN), P, (const bf16_t*)(ws + OFF_V), MIX, h, s);
                        }
                    } else {
                        const bf16_t* CZ = (const bf16_t*)(ws + OFF_CZ); const bf16_t* BG = (const bf16_t*)(ws + OFF_BG); bf16_t* Gb = (bf16_t*)(ws + OFF_G);
                        const float* cw = p.in[21] + (size_t)e * 3 * DM;
                        LAUNDER_TID();
                        for (int idx = bid * NTHREADS + tid; idx < S * 128; idx += G * NTHREADS) {
                            const int t = idx >> 7, c8 = (idx & 127) * 8;
                            const u32x4 z0 = *(const u32x4*)(CZ + (size_t)t * DM + c8);
                            const u32x4 z1 = t >= 1 ? *(const u32x4*)(CZ + (size_t)(t - 1) * DM + c8) : (u32x4){0u, 0u, 0u, 0u};
                            const u32x4 z2 = t >= 2 ? *(const u32x4*)(CZ + (size_t)(t - 2) * DM + c8) : (u32x4){0u, 0u, 0u, 0u};
                            const u32x4 bg = *(const u32x4*)(BG + (size_t)t * DM + c8);
                            float o[8];
#pragma unroll
                            for (int i = 0; i < 4; ++i) {
#pragma unroll
                                for (int hlf = 0; hlf < 2; ++hlf) {
                                    const int c = c8 + 2 * i + hlf;
                                    const float a0 = hlf ? __uint_as_float(z0[i] & 0xffff0000u) : __uint_as_float(z0[i] << 16);
                                    const float a1 = hlf ? __uint_as_float(z1[i] & 0xffff0000u) : __uint_as_float(z1[i] << 16);
                                    const float a2 = hlf ? __uint_as_float(z2[i] & 0xffff0000u) : __uint_as_float(z2[i] << 16);
                                    const float bb = hlf ? __uint_as_float(bg[i] & 0xffff0000u) : __uint_as_float(bg[i] << 16);
                                    o[2 * i + hlf] = bb * (cw[c] * a2 + cw[DM + c] * a1 + cw[2 * DM + c] * a0);
                                }
                            }
                            u32x4 w; w.x = pk_bf16(o[0], o[1]); w.y = pk_bf16(o[2], o[3]); w.z = pk_bf16(o[4], o[5]); w.w = pk_bf16(o[6], o[7]);
                            *(u32x4*)(Gb + (size_t)t * DM + c8) = w;
                        }
                    }
                }
                SYNC();
            }
            if (RUN) {
                pg8::Gemm g; pg8::StaticOrder So; EpiRes E;
                g.M = S; g.N = DM;
                if (is_ffn) { g.A = (const bf16_t*)(ws + OFF_ACT); g.K = FF; g.lda = FF; g.ldb = FF; g.Bt = (const bf16_t*)(ws + OFF_WD) + (size_t)(2 * l + (sub == 2)) * DM * FF; E.alpha = 0.5f; }
                else if (even) { g.A = (const bf16_t*)(ws + OFF_MIX); g.K = DM; g.lda = DM; g.ldb = DM; g.Bt = (const bf16_t*)(ws + OFF_WOUT) + (size_t)e * DM * DM; E.alpha = 1.0f; }
                else { g.A = (const bf16_t*)(ws + OFF_G); g.K = DM; g.lda = DM; g.ldb = DM; g.Bt = (const bf16_t*)(ws + OFF_WCOUT) + (size_t)e * DM * DM; E.alpha = 1.0f; }
                E.XB = XB; E.ss_out = ss_out;
                So.init(S, DM, G, bid);
                pg8::gemm_phase<EpiRes, pg8::StaticOrder, true, true>(lds, g, So, E);
            }
            SYNC();
        }
    }
    if (RUN) {
        const float* gn = p.in[23];
        LAUNDER_TID();
        for (int row = gw; row < S; row += ngw) {
            const u32x2* xr = (const u32x2*)(XB + (size_t)row * DM) + lane;
            f32x4 v[4]; float s = 0.f;
#pragma unroll
            for (int j = 0; j < 4; ++j) {
                const u32x2 w = xr[64 * j];
                v[j] = (f32x4){__uint_as_float(w.x << 16), __uint_as_float(w.x & 0xffff0000u), __uint_as_float(w.y << 16), __uint_as_float(w.y & 0xffff0000u)};
                s += (v[j][0] * v[j][0] + v[j][1] * v[j][1]) + (v[j][2] * v[j][2] + v[j][3] * v[j][3]);
            }
#pragma unroll
            for (int o = 1; o < 64; o <<= 1) s += __shfl_xor(s, o);
            const float rs = rsqrtf(s * (1.0f / DM) + EPS);
            f32x4* orow = (f32x4*)(p.out + (size_t)row * DM) + lane;
#pragma unroll
            for (int j = 0; j < 4; ++j) { const f32x4 gg = ((const f32x4*)gn + lane)[64 * j]; orow[64 * j] = v[j] * rs * gg; }
        }
    }
#undef RUN
#undef SYNC
}

#ifndef MK_MULTI
#define MK_MULTI 0
#endif
extern "C" void kernel_launch(void* const* d_in, const int* in_sizes, int n_in, void* d_out, int out_size, void* d_ws, size_t ws_size, hipStream_t stream) {
    static int grid = 0;
    if (grid == 0) {
        if (n_in != 24 || out_size != S * DM || ws_size < WS_END) { fprintf(stderr, "kernel_launch: unexpected problem (n_in %d out %d ws %zu)\n", n_in, out_size, ws_size); grid = -1; return; }
        int dev = 0, cus = 0, per_cu = 0;
        hipGetDevice(&dev);
        hipDeviceGetAttribute(&cus, hipDeviceAttributeMultiprocessorCount, dev);
        if (hipFuncSetAttribute((const void*)mega_fwd, hipFuncAttributeMaxDynamicSharedMemorySize, LDS_BYTES) != hipSuccess) { fprintf(stderr, "hipFuncSetAttribute failed\n"); grid = -1; return; }
        if (hipOccupancyMaxActiveBlocksPerMultiprocessor(&per_cu, (const void*)mega_fwd, NTHREADS, LDS_BYTES) != hipSuccess || per_cu < 1) { fprintf(stderr, "occupancy query failed (%d)\n", per_cu); per_cu = 1; }
        (void)hipGetLastError();
        if (per_cu > 1) per_cu = 1;
        grid = cus * per_cu;
    }
    if (grid < 0) return;
    (void)hipMemsetAsync((char*)d_ws + OFF_BAR, 0, XCD_BAR_WORDS * sizeof(unsigned), stream);
    Params p{};
    for (int i = 0; i < 24; ++i) p.in[i] = (const float*)d_in[i];
    p.out = (float*)d_out; p.ws = (unsigned char*)d_ws;
    for (int i = 0; i < 16; ++i) p.inv_freq[i] = (float)pow(10000.0, -(double)i / 16.0);
#if MK_MULTI
    for (int s = 0; s < 40; ++s) {
        p.step_lo = s; p.step_hi = s + 1;
        hipLaunchKernelGGL(mega_fwd, dim3(grid), dim3(NTHREADS), LDS_BYTES, stream, p);
    }
#else
    p.step_lo = 0; p.step_hi = 1000;
    void* args[] = {&p};
    hipError_t e = hipLaunchCooperativeKernel((const void*)mega_fwd, dim3(grid), dim3(NTHREADS), args, LDS_BYTES, stream);
    if (e != hipSuccess) fprintf(stderr, "cooperative launch failed: %s (grid %d)\n", hipGetErrorString(e), grid);
#endif
}
```

```cpp
#include <hip/hip_runtime.h>
#include <hip/hip_cooperative_groups.h>
#include <cstdio>
#include <cstdint>
#include <cmath>
namespace cg = cooperative_groups;
namespace pg8 {
#define PG8_LAS __attribute__((address_space(3)))
typedef unsigned short bf16_t;
typedef short bf16x8 __attribute__((ext_vector_type(8)));
typedef float f32x4 __attribute__((ext_vector_type(4)));
typedef unsigned u32x4 __attribute__((ext_vector_type(4)));
constexpr int BM = 256, BK = 64, HALF = 128, HTB = HALF * BK * 2  , STAGE_BYTES = 8 * HTB, NXCD = 8, WGM = 8;

__host__ __device__ __forceinline__ int lds_byte(int r, int c) { const int st = (r >> 4) * 2 + (c >> 5), rr = r & 15, cc = c & 31, ob = rr * 64 + cc * 2; return st * 1024 + (ob ^ (((ob >> 9) & 1) << 5)); }
__host__ __device__ __forceinline__ void stage_rc(int b, int& R, int& C) { const int st = b / 1024, sb = b % 1024, swz = sb ^ (((sb >> 9) & 1) << 5); R = (st >> 1) * 16 + swz / 64; C = (st & 1) * 32 + (swz % 64) / 2; }
__host__ __device__ __forceinline__ int perm32(int rho) { const int n = rho >> 4, i = rho & 15; return 8 * (i >> 2) + 4 * n + (i & 3); }

struct Unit { int pm, pn; };
struct Gemm { const bf16_t* A; const bf16_t* Bt; int M, N, K, lda, ldb; };

struct StaticOrder {
    int nM, nN, nwg, G, c;
    __host__ __device__ void init(int M, int N, int G_, int c_) { nM = M / BM; nN = N / BM; nwg = nM * nN; G = G_; c = c_; }
    __host__ __device__ bool next(int i, Unit& u) const {
        const long L = (long)i * G + c; if (L >= nwg) return false;
        int wgid = (int)L; { const int q = nwg / NXCD, r = nwg % NXCD, xcd = wgid % NXCD, off = wgid / NXCD; wgid = (xcd < r ? xcd * (q + 1) : r * (q + 1) + (xcd - r) * q) + off; }
        const int nig = WGM * nN, gid = wgid / nig, fm = gid * WGM, gsz = (nM - fm) < WGM ? (nM - fm) : WGM;
        u.pm = fm + ((wgid % nig) % gsz); u.pn = (wgid % nig) / gsz; return true;
    }
    __device__ __forceinline__ void a_ready(const Unit&) const {}
    __device__ __forceinline__ void done(const Unit&) const {}
};

__device__ __forceinline__ unsigned cvt_pk_bf16(float lo, float hi) { unsigned r; asm volatile("v_cvt_pk_bf16_f32 %0, %1, %2" : "=v"(r) : "v"(lo), "v"(hi)); return r; }
typedef float f32x2 __attribute__((ext_vector_type(2)));
__device__ __forceinline__ f32x2 gelu_pk(f32x2 v) {
    const f32x2 av = __builtin_elementwise_abs(v), d = av * 0.2316418882f + 1.0f;
    f32x2 t; t.x = __builtin_amdgcn_rcpf(d.x); t.y = __builtin_amdgcn_rcpf(d.y);
    f32x2 q = t * 0.5307027145f + (-0.7265760135f); q = q * t + 0.7107068705f; q = q * t + (-0.142248368f); q = q * t + 0.127414796f; q = q * t;
    const f32x2 s = (v * v) * (-0.72134752044f);
    f32x2 e; e.x = __builtin_amdgcn_exp2f(s.x); e.y = __builtin_amdgcn_exp2f(s.y);
    const f32x2 m = v * (q * e), r = v - m;
    f32x2 o; o.x = v.x < 0.f ? m.x : r.x; o.y = v.y < 0.f ? m.y : r.y; return o;
}
template <class Epi, class Sched, bool ALIGN_EPI = false, bool SP2 = false>
__device__ __forceinline__ void gemm_phase(PG8_LAS unsigned char* lds, const Gemm g, const Sched& S, const Epi& E) {
    int tid_l = threadIdx.x; asm volatile("" : "+v"(tid_l)); const int tid = tid_l, wid = __builtin_amdgcn_readfirstlane(tid >> 6), lane = tid & 63, wr = wid >> 2, wc = wid & 3, fr = lane & 15, fq = lane >> 4;
    const int K = g.K, nt = K / BK;
    unsigned voffA[2], voffB[2];
#pragma unroll
    for (int i = 0; i < 2; ++i) { int R, C; stage_rc(tid * 16 + i * 8192, R, C); const int Rb = Epi::PERM ? ((R & ~31) + perm32(R & 31)) : R;
        voffA[i] = (unsigned)(R * g.lda + C) * 2u; voffB[i] = (unsigned)(Rb * g.ldb + C) * 2u; }
    const size_t kstep = (size_t)(BK * 2);
    const size_t hstepA = (size_t)HALF * g.lda * 2, hstepB = (size_t)HALF * g.ldb * 2;
    const size_t tstepA = 2 * hstepA, tstepB = 2 * hstepB;
    const unsigned ldsw = (unsigned)wid * 1024u;
    const int aoff = lds_byte(wr * 64 + fr, fq * 8), boff = lds_byte(wc * 32 + fr, fq * 8);
#define PG8_SA(b, h) (((b) * 2 + (h)) * HTB)
#define PG8_SB(b, h) ((4 + (b) * 2 + (h)) * HTB)
#define PG8_STAGE(bufoff, gbase, voff) do { _Pragma("unroll") for (int _i = 0; _i < 2; ++_i) \
        __builtin_amdgcn_global_load_lds((const unsigned*)((const char*)(gbase) + (voff)[_i]), (PG8_LAS unsigned*)(lds + (bufoff) + ldsw + _i * 8192), 16, 0, 0); } while (0)
#define PG8_LDA(dst, b, h) do { _Pragma("unroll") for (int m = 0; m < 4; ++m) _Pragma("unroll") for (int k = 0; k < 2; ++k) dst[m][k] = *(const PG8_LAS bf16x8*)(lds + PG8_SA(b, h) + aoff + m * 2048 + k * 1024); } while (0)
#define PG8_LDB(dst, b, h) do { _Pragma("unroll") for (int n = 0; n < 2; ++n) _Pragma("unroll") for (int k = 0; k < 2; ++k) dst[n][k] = *(const PG8_LAS bf16x8*)(lds + PG8_SB(b, h) + boff + n * 2048 + k * 1024); } while (0)
#define PG8_MMA(ai, bj, At, Bt) do { __builtin_amdgcn_s_setprio(1); _Pragma("unroll") for (int m = 0; m < 4; ++m) _Pragma("unroll") for (int n = 0; n < 2; ++n) _Pragma("unroll") for (int k = 0; k < 2; ++k) \
        acc[ai][bj][m][n] = __builtin_amdgcn_mfma_f32_16x16x32_bf16(Bt[n][k], At[m][k], acc[ai][bj][m][n], 0, 0, 0); __builtin_amdgcn_s_setprio(0); } while (0)
#define PG8_WAIT_V(n) asm volatile("s_waitcnt vmcnt(" #n ")" ::: "memory")
#define PG8_WAIT_L(n) asm volatile("s_waitcnt lgkmcnt(" #n ")" ::: "memory")
#define PG8_BAR __builtin_amdgcn_s_barrier()
#define PG8_SCHED __builtin_amdgcn_sched_barrier(0)
    Unit cur, nxt; int ui = 0;
    if (!S.next(0, cur)) return;
    f32x4 acc[2][2][4][2];
#pragma unroll
    for (int a = 0; a < 2; ++a)
#pragma unroll
        for (int b = 0; b < 2; ++b)
#pragma unroll
            for (int m = 0; m < 4; ++m)
#pragma unroll
                for (int n = 0; n < 2; ++n) acc[a][b][m][n] = (f32x4){0.f, 0.f, 0.f, 0.f};
    bf16x8 At[4][2], B0[2][2], B1[2][2];
    const char* cA = (const char*)g.A + (size_t)cur.pm * tstepA; const char* cB = (const char*)g.Bt + (size_t)cur.pn * tstepB;
    S.a_ready(cur);
    if constexpr (SP2) {
        PG8_STAGE(PG8_SB(0, 0), cB, voffB); PG8_STAGE(PG8_SB(0, 1), cB + hstepB, voffB); PG8_STAGE(PG8_SA(0, 0), cA, voffA); PG8_STAGE(PG8_SA(0, 1), cA + hstepA, voffA);
        if (wr == 1) PG8_BAR;
        PG8_WAIT_V(2); PG8_BAR;
        PG8_STAGE(PG8_SB(1, 0), cB + kstep, voffB); PG8_STAGE(PG8_SA(1, 0), cA + kstep, voffA); PG8_STAGE(PG8_SB(1, 1), cB + hstepB + kstep, voffB);
        PG8_WAIT_V(6); PG8_BAR;
    } else {
        PG8_STAGE(PG8_SB(0, 0), cB, voffB); PG8_STAGE(PG8_SA(0, 0), cA, voffA); PG8_STAGE(PG8_SB(0, 1), cB + hstepB, voffB); PG8_STAGE(PG8_SA(0, 1), cA + hstepA, voffA);
        if (wr == 1) PG8_BAR;
        PG8_WAIT_V(4); PG8_BAR;
        PG8_STAGE(PG8_SB(1, 0), cB + kstep, voffB); PG8_STAGE(PG8_SA(1, 0), cA + kstep, voffA); PG8_STAGE(PG8_SB(1, 1), cB + hstepB + kstep, voffB);
        PG8_WAIT_V(6); PG8_BAR;
    }
    for (;;) {
        const bool has_next = S.next(ui + 1, nxt);
        const char* nA = has_next ? (const char*)g.A + (size_t)nxt.pm * tstepA : cA; const char* nB = has_next ? (const char*)g.Bt + (size_t)nxt.pn * tstepB : cB;
        for (int t = 0; t < nt; t += 2) {
            const bool last = (t == nt - 2);
            const char* a1 = cA + (size_t)(t + 1) * kstep;
            const char* a2 = last ? nA : cA + (size_t)(t + 2) * kstep; const char* b2 = last ? nB : cB + (size_t)(t + 2) * kstep;
            const char* a3 = a2 + kstep; const char* b3 = b2 + kstep;
            if (last && has_next) S.a_ready(nxt);
            if constexpr (SP2) {
            PG8_LDB(B0, 0, 0); PG8_LDB(B1, 0, 1); PG8_SCHED; PG8_LDA(At, 0, 0); PG8_STAGE(PG8_SA(1, 1), a1 + hstepA, voffA);
            PG8_WAIT_V(8); PG8_WAIT_L(0); PG8_BAR; PG8_MMA(0, 0, At, B0); PG8_MMA(0, 1, At, B1); PG8_BAR; PG8_SCHED;
            PG8_LDA(At, 0, 1); PG8_STAGE(PG8_SB(0, 0), b2, voffB); PG8_STAGE(PG8_SB(0, 1), b2 + hstepB, voffB); PG8_STAGE(PG8_SA(0, 0), a2, voffA);
            PG8_WAIT_V(8); PG8_WAIT_L(0); PG8_BAR; PG8_MMA(1, 0, At, B0); PG8_MMA(1, 1, At, B1); PG8_BAR; PG8_SCHED;
            PG8_LDB(B0, 1, 0); PG8_LDB(B1, 1, 1); PG8_SCHED; PG8_LDA(At, 1, 0); PG8_STAGE(PG8_SA(0, 1), a2 + hstepA, voffA);
            PG8_WAIT_V(8); PG8_WAIT_L(0); PG8_BAR; PG8_MMA(0, 0, At, B0); PG8_MMA(0, 1, At, B1); PG8_BAR; PG8_SCHED;
            PG8_LDA(At, 1, 1); PG8_STAGE(PG8_SB(1, 0), b3, voffB); PG8_STAGE(PG8_SB(1, 1), b3 + hstepB, voffB); PG8_STAGE(PG8_SA(1, 0), a3, voffA);
            PG8_WAIT_V(8); PG8_WAIT_L(0); PG8_BAR; PG8_MMA(1, 0, At, B0); PG8_MMA(1, 1, At, B1); PG8_BAR; PG8_SCHED;
            } else {
            PG8_LDB(B0, 0, 0); PG8_SCHED; PG8_LDA(At, 0, 0); PG8_STAGE(PG8_SA(1, 1), a1 + hstepA, voffA);
            PG8_WAIT_L(8); PG8_BAR; PG8_WAIT_L(0); PG8_MMA(0, 0, At, B0); PG8_BAR; PG8_SCHED;
            PG8_LDB(B1, 0, 1); PG8_STAGE(PG8_SB(0, 0), b2, voffB);
            PG8_BAR; PG8_WAIT_L(0); PG8_MMA(0, 1, At, B1); PG8_BAR;
            PG8_LDA(At, 0, 1); PG8_STAGE(PG8_SA(0, 0), a2, voffA);
            PG8_BAR; PG8_WAIT_L(0); PG8_MMA(1, 0, At, B0); PG8_BAR; PG8_SCHED;
            PG8_STAGE(PG8_SB(0, 1), b2 + hstepB, voffB);
            PG8_WAIT_V(6); PG8_BAR; PG8_MMA(1, 1, At, B1); PG8_BAR;
            PG8_LDB(B0, 1, 0); PG8_SCHED; PG8_LDA(At, 1, 0); PG8_STAGE(PG8_SA(0, 1), a2 + hstepA, voffA);
            PG8_WAIT_L(8); PG8_BAR; PG8_WAIT_L(0); PG8_MMA(0, 0, At, B0); PG8_BAR; PG8_SCHED;
            PG8_LDB(B1, 1, 1); PG8_STAGE(PG8_SB(1, 0), b3, voffB);
            PG8_BAR; PG8_WAIT_L(0); PG8_MMA(0, 1, At, B1); PG8_BAR;
            PG8_LDA(At, 1, 1); PG8_STAGE(PG8_SA(1, 0), a3, voffA);
            PG8_BAR; PG8_WAIT_L(0); PG8_MMA(1, 0, At, B0); PG8_BAR; PG8_SCHED;
            PG8_STAGE(PG8_SB(1, 1), b3 + hstepB, voffB);
            PG8_WAIT_V(6); PG8_BAR; PG8_MMA(1, 1, At, B1); PG8_BAR;
            }
        }
        if constexpr (ALIGN_EPI) { if (wr == 0) PG8_BAR; }
        if constexpr (!Epi::AFTER_DRAIN) { E(acc, cur, wr, wc, fr, fq); S.done(cur); }
        if (!has_next) break;
#pragma unroll
        for (int a = 0; a < 2; ++a)
#pragma unroll
            for (int b = 0; b < 2; ++b)
#pragma unroll
                for (int m = 0; m < 4; ++m)
#pragma unroll
                    for (int n = 0; n < 2; ++n) acc[a][b][m][n] = (f32x4){0.f, 0.f, 0.f, 0.f};
        cur = nxt; cA = nA; cB = nB; ++ui;
        if constexpr (ALIGN_EPI) { if (wr == 1) PG8_BAR; }
    }
    PG8_WAIT_V(0);
    if constexpr (!ALIGN_EPI) { if (wr == 0) PG8_BAR; }
    PG8_BAR;
    if constexpr (Epi::AFTER_DRAIN) { E.fused(acc, cur, wr, wc, fr, fq, lds, wid, lane); S.done(cur); }
#undef PG8_SA
#undef PG8_SB
#undef PG8_STAGE
#undef PG8_LDA
#undef PG8_LDB
#undef PG8_MMA
#undef PG8_WAIT_V
#undef PG8_WAIT_L
#undef PG8_BAR
#undef PG8_SCHED
}
}
#define LAS __attribute__((address_space(3)))
#define XB_TMO      128
#define XB_XCNT(j)  (256  + 64 * (j))
#define XB_XSUB(j)  (1280 + 64 * (j))
#define XB_XGEN(j)  (2304 + 64 * (j))
#define XB_TOP      3328
#define XB_TOPGEN   3392
#define XCD_BAR_WORDS 3456
#define XB_SPIN_CAP (1u << 18)

__device__ __forceinline__ unsigned xb_ld(unsigned* p)              { return __hip_atomic_load(p, __ATOMIC_RELAXED, __HIP_MEMORY_SCOPE_AGENT); }
__device__ __forceinline__ unsigned xb_add(unsigned* p, unsigned v) { return __hip_atomic_fetch_add(p, v, __ATOMIC_RELAXED, __HIP_MEMORY_SCOPE_AGENT); }
__device__ __forceinline__ unsigned xb_xcc_id() { return (unsigned)__builtin_amdgcn_s_getreg((3 << 11) | 20) & 0xFu; }
#define XB_SPIN(cond, bar) do { unsigned _sp = 0; while (cond) { __builtin_amdgcn_s_sleep(1); \
    if ((++_sp & 255u) == 0u) { if (xb_ld(&(bar)[XB_TMO])) break; if (_sp > XB_SPIN_CAP) { atomicAdd(&(bar)[XB_TMO], 1u); break; } } } } while (0)

struct XcdBarrier {
    unsigned* bar; unsigned x;
    volatile LAS unsigned* st;
};

__device__ __forceinline__ XcdBarrier xcd_barrier_post(unsigned* bar, volatile LAS unsigned* st) {
    XcdBarrier b; b.bar = bar; b.x = xb_xcc_id(); b.st = st;
    if (threadIdx.x == 0) (void)xb_add(&bar[XB_XCNT(b.x)], 1u);
    return b;
}
__device__ __forceinline__ void xcd_barrier_complete(unsigned* bar, unsigned x, unsigned& nloc, unsigned& nx) {
    const unsigned G = gridDim.x * gridDim.y * gridDim.z;
    unsigned sum, cnt, mine, sp = 0u;
    for (;;) {
        sum = 0u; cnt = 0u; mine = 0u;
#pragma unroll
        for (unsigned j = 0; j < 16; ++j) { const unsigned c = xb_ld(&bar[XB_XCNT(j)]); sum += c; cnt += (c > 0u) ? 1u : 0u; mine = (j == x) ? c : mine; }
        if (sum == G) break;
        __builtin_amdgcn_s_sleep(1);
        if ((++sp & 255u) == 0u) { if (xb_ld(&bar[XB_TMO])) break; if (sp > XB_SPIN_CAP) { atomicAdd(&bar[XB_TMO], 1u); break; } }
    }
    nloc = mine > 0u ? mine : 1u; nx = cnt > 0u ? cnt : 1u;
}

__device__ __forceinline__ void xcd_barrier(const XcdBarrier& b) {
    asm volatile("s_waitcnt vmcnt(0)" ::: "memory");
    __syncthreads();
    if (threadIdx.x == 0) {
        unsigned* bar = b.bar;
        __builtin_amdgcn_s_waitcnt(0);
        unsigned nloc = b.st[0], nx = b.st[1];
        if (nloc == 0u) { xcd_barrier_complete(bar, b.x, nloc, nx); b.st[0] = nloc; b.st[1] = nx; }
        const unsigned old = xb_add(&bar[XB_XSUB(b.x)], 1u);
        const unsigned gen = old / nloc;
        if (old + 1u == (gen + 1u) * nloc) {
            __builtin_amdgcn_fence(__ATOMIC_RELEASE, "agent");
            asm volatile("s_waitcnt vmcnt(0)" ::: "memory");
            const unsigned og = xb_add(&bar[XB_TOP], 1u);
            const unsigned tg = og / nx;
            if (og + 1u == (tg + 1u) * nx) xb_add(&bar[XB_TOPGEN], 1u);
            else XB_SPIN(xb_ld(&bar[XB_TOPGEN]) == tg, bar);
            __builtin_amdgcn_fence(__ATOMIC_ACQUIRE, "agent");
            xb_add(&bar[XB_XGEN(b.x)], 1u);
            asm volatile("s_waitcnt vmcnt(0)" ::: "memory");
        } else {
            XB_SPIN(xb_ld(&bar[XB_XGEN(b.x)]) == gen, bar);
            __builtin_amdgcn_fence(__ATOMIC_ACQUIRE, "agent");
            asm volatile("s_waitcnt vmcnt(0)" ::: "memory");
        }
    }
    __syncthreads();
}

typedef unsigned short bf16_t;
typedef short bf16x8 __attribute__((ext_vector_type(8)));
typedef short s16x4 __attribute__((ext_vector_type(4)));
typedef float f32x4 __attribute__((ext_vector_type(4)));
typedef float f32x2 __attribute__((ext_vector_type(2)));
typedef float f32x16 __attribute__((ext_vector_type(16)));
typedef unsigned u32x4 __attribute__((ext_vector_type(4)));
typedef unsigned u32x2 __attribute__((ext_vector_type(2)));

constexpr int S = 16384, DM = 1024, FF = 2816, NGU = 2 * FF;
constexpr int PW = 1792;
constexpr int P_CQ = 0, P_CKV = 384, P_KR = 640, P_U = 768, P_V = 1280;
constexpr int QW = 768;
constexpr float EPS = 1e-6f;
constexpr int NTHREADS = 512, NWAVES = 8;
constexpr int LDS_BYTES = 147456;
constexpr int LDS_MISC = 131072;

constexpr size_t MiB = (size_t)1 << 20;
constexpr size_t OFF_SS = 342 * MiB;
constexpr size_t OFF_ROPE = 2 * MiB;
constexpr size_t OFF_WGU = 4 * MiB;
constexpr size_t OFF_WD = 92 * MiB;
constexpr size_t OFF_WIN = 136 * MiB;
constexpr size_t OFF_WUQ = 143 * MiB;
constexpr size_t OFF_WUKV = 145 * MiB;
constexpr size_t OFF_WOUT = 146 * MiB;
constexpr size_t OFF_WCIN = 150 * MiB;
constexpr size_t OFF_WCOUT = 162 * MiB;
constexpr size_t OFF_XB = 166 * MiB;
constexpr size_t OFF_ACT = 198 * MiB;
constexpr size_t OFF_P = OFF_ACT, OFF_Q = OFF_ACT + 56 * MiB, OFF_KN = OFF_ACT + 80 * MiB, OFF_V = OFF_ACT + 96 * MiB, OFF_MIX = OFF_ACT + 112 * MiB;
constexpr size_t OFF_CZ = OFF_ACT, OFF_BG = OFF_ACT + 32 * MiB, OFF_G = OFF_ACT + 64 * MiB;
constexpr size_t OFF_BAR = 361 * MiB;
constexpr size_t OFF_WSG = 362 * MiB;
constexpr size_t WS_END = 363 * MiB;

struct Params {
    const float* in[24];
    float* out;
    unsigned char* ws;
    float inv_freq[16];
    int step_lo, step_hi;
};

__device__ __forceinline__ float bf2f(unsigned short b) { return __uint_as_float((unsigned)b << 16); }
__device__ __forceinline__ unsigned pk_bf16(float lo, float hi) { return pg8::cvt_pk_bf16(lo, hi); }
__device__ __forceinline__ int crow(int r, int h) { return (r & 3) + 8 * (r >> 2) + 4 * h; }
__device__ __forceinline__ float swap32_max(float v) {
    auto rr = __builtin_amdgcn_permlane32_swap(__float_as_uint(v), __float_as_uint(v), false, false);
    return fmaxf(__uint_as_float(rr[0]), __uint_as_float(rr[1]));
}
__device__ __forceinline__ float swap32_sum(float v) {
    auto rr = __builtin_amdgcn_permlane32_swap(__float_as_uint(v), __float_as_uint(v), false, false);
    return __uint_as_float(rr[0]) + __uint_as_float(rr[1]);
}

__device__ __forceinline__ float row_ss(const float* st, int row, int nsl) {
    const f32x4* q = (const f32x4*)(st + (size_t)row * 16);
    const f32x4 a = q[0], b = q[1];
    float s = ((a[0] + a[1]) + (a[2] + a[3])) + ((b[0] + b[1]) + (b[2] + b[3]));
    if (nsl > 8) { const f32x4 c = q[2]; s += (c[0] + c[1]) + (c[2] + c[3]); }
    if (nsl > 12) { const f32x4 d = q[3]; s += (d[0] + d[1]) + (d[2] + d[3]); }
    return s;
}
__device__ __forceinline__ f32x4 row_ss_part(const float* st, int row, int nsl, int fq) {
    return (4 * fq < nsl) ? ((const f32x4*)(st + (size_t)row * 16))[fq] : (f32x4){0.f, 0.f, 0.f, 0.f};
}
__device__ __forceinline__ float row_ss_fin(const f32x4 v) {
    float s = (v[0] + v[1]) + (v[2] + v[3]);
    s += __shfl_xor(s, 16); s += __shfl_xor(s, 32);
    return s;
}

struct EpiPair {
    static constexpr bool PERM = true, AFTER_DRAIN = false;
    bf16_t* O; int ldo; const float* ss; float inv_dim; int mode;
    __device__ __forceinline__ void operator()(const f32x4 (&acc)[2][2][4][2], const pg8::Unit& u, int wr, int wc, int fr, int fq) const {
        const int row0 = u.pm * 256 + wr * 64 + fr, col0 = u.pn * 128 + wc * 32 + 8 * fq;
        f32x4 sp[2][4]; float rsv[2][4];
#pragma unroll
        for (int ai = 0; ai < 2; ++ai)
#pragma unroll
            for (int m = 0; m < 4; ++m) sp[ai][m] = row_ss_part(ss, row0 + ai * 128 + m * 16, 16, fq);
#pragma unroll
        for (int ai = 0; ai < 2; ++ai)
#pragma unroll
            for (int m = 0; m < 4; ++m) rsv[ai][m] = rsqrtf(row_ss_fin(sp[ai][m]) * inv_dim + EPS);
        if (mode == 0) {
#pragma unroll
            for (int ai = 0; ai < 2; ++ai)
#pragma unroll
                for (int m = 0; m < 4; ++m) {
                    const int row = row0 + ai * 128 + m * 16;
                    const float rs = rsv[ai][m], c1 = rs * -1.4426950408889634f, rs2 = rs * rs;
                    f32x2 h[4];
#pragma unroll
                    for (int n = 0; n < 2; ++n)
#pragma unroll
                        for (int q = 0; q < 2; ++q) {
                            const f32x2 A = {acc[ai][0][m][n][2 * q], acc[ai][0][m][n][2 * q + 1]}, B = {acc[ai][1][m][n][2 * q], acc[ai][1][m][n][2 * q + 1]};
                            const f32x2 ab = A * B, ea = A * c1;
                            f32x2 d; d.x = __builtin_amdgcn_exp2f(ea.x); d.y = __builtin_amdgcn_exp2f(ea.y);
                            d = d + 1.0f;
                            f32x2 r; r.x = __builtin_amdgcn_rcpf(d.x); r.y = __builtin_amdgcn_rcpf(d.y);
                            h[n * 2 + q] = ab * (r * rs2);
                        }
                    u32x4 w; w.x = pk_bf16(h[0].x, h[0].y); w.y = pk_bf16(h[1].x, h[1].y); w.z = pk_bf16(h[2].x, h[2].y); w.w = pk_bf16(h[3].x, h[3].y);
                    *(u32x4*)(O + (size_t)row * ldo + col0) = w;
                }
        } else {
#pragma unroll
            for (int ai = 0; ai < 2; ++ai)
#pragma unroll
                for (int m = 0; m < 4; ++m) {
                    const int row = row0 + ai * 128 + m * 16;
                    const float rs2 = rsv[ai][m] * rsv[ai][m];
                    f32x2 h[4];
#pragma unroll
                    for (int n = 0; n < 2; ++n)
#pragma unroll
                        for (int q = 0; q < 2; ++q) {
                            const f32x2 A = {acc[ai][0][m][n][2 * q], acc[ai][0][m][n][2 * q + 1]}, B = {acc[ai][1][m][n][2 * q], acc[ai][1][m][n][2 * q + 1]};
                            h[n * 2 + q] = (A * B) * rs2;
                        }
                    u32x4 w; w.x = pk_bf16(h[0].x, h[0].y); w.y = pk_bf16(h[1].x, h[1].y); w.z = pk_bf16(h[2].x, h[2].y); w.w = pk_bf16(h[3].x, h[3].y);
                    *(u32x4*)(O + (size_t)row * ldo + col0) = w;
                }
        }
    }
};

struct EpiRes {
    static constexpr bool PERM = true, AFTER_DRAIN = false;
    bf16_t* XB; float* ss_out; float alpha;
    __device__ __forceinline__ void operator()(const f32x4 (&acc)[2][2][4][2], const pg8::Unit& u, int wr, int wc, int fr, int fq) const {
        const int row0 = u.pm * 256 + wr * 64 + fr, col0 = u.pn * 256 + wc * 32 + 8 * fq;
#pragma unroll
        for (int ai = 0; ai < 2; ++ai)
#pragma unroll
            for (int m = 0; m < 4; ++m) {
                const int row = row0 + ai * 128 + m * 16;
                float sq = 0.f;
#pragma unroll
                for (int bj = 0; bj < 2; ++bj) {
                    bf16_t* px = XB + (size_t)row * DM + col0 + bj * 128;
                    const u32x4 xo = *(const u32x4*)px;
                    u32x4 w;
#pragma unroll
                    for (int i = 0; i < 4; ++i) {
                        const float lo = __uint_as_float(xo[i] << 16) + acc[ai][bj][m][i >> 1][(i & 1) * 2] * alpha;
                        const float hi = __uint_as_float(xo[i] & 0xffff0000u) + acc[ai][bj][m][i >> 1][(i & 1) * 2 + 1] * alpha;
                        const unsigned pk = pk_bf16(lo, hi);
                        w[i] = pk;
                        const float rl = __uint_as_float(pk << 16), rh = __uint_as_float(pk & 0xffff0000u);
                        sq += rl * rl + rh * rh;
                    }
                    *(u32x4*)px = w;
                }
                sq += __shfl_xor(sq, 16); sq += __shfl_xor(sq, 32);
                if (fq == 0) ss_out[(size_t)row * 16 + u.pn * 4 + wc] = sq;
                asm volatile("" ::: "memory");
            }
    }
};

struct EpiRow {
    static constexpr bool PERM = true, AFTER_DRAIN = false;
    bf16_t* O; int ldo; int split_tiles; size_t split_stride;
    const float* ss; float inv_dim; int nsl;
    int gelu_from; int rope_pn, rope_bj, rope_wc;
    const float* cs; const float* sn;
    unsigned long long stat_map; float* stb;
    __device__ __forceinline__ void operator()(const f32x4 (&acc)[2][2][4][2], const pg8::Unit& u, int wr, int wc, int fr, int fq) const {
        const int row0 = u.pm * 256 + wr * 64 + fr;
        int colt = u.pn * 256; bf16_t* base = O;
        if (split_tiles && u.pn >= split_tiles) { base += split_stride; colt -= split_tiles * 256; }
        const bool do_gelu = u.pn >= gelu_from;
        f32x4 sp[2][4]; float rsv[2][4];
#pragma unroll
        for (int ai = 0; ai < 2; ++ai)
#pragma unroll
            for (int m = 0; m < 4; ++m) sp[ai][m] = row_ss_part(ss, row0 + ai * 128 + m * 16, nsl, fq);
#pragma unroll
        for (int ai = 0; ai < 2; ++ai)
#pragma unroll
            for (int m = 0; m < 4; ++m) rsv[ai][m] = rsqrtf(row_ss_fin(sp[ai][m]) * inv_dim + EPS);
#pragma unroll
        for (int bj = 0; bj < 2; ++bj) {
            const bool do_rope = (u.pn == rope_pn) && (rope_bj < 0 || (bj == rope_bj && wc == rope_wc));
            const int sidx = (int)((stat_map >> (4 * (u.pn * 2 + bj))) & 15ull);
            float* st = stb + (size_t)(sidx > 0 ? sidx - 1 : 0) * ((size_t)S * 16);
            const int sbase = (int)((0x0a0300u >> (8 * (sidx > 0 ? sidx - 1 : 0))) & 255u);
            const int col0 = colt + bj * 128 + wc * 32 + 8 * fq;
#pragma unroll
            for (int ai = 0; ai < 2; ++ai)
#pragma unroll
                for (int m = 0; m < 4; ++m) {
                    const int row = row0 + ai * 128 + m * 16;
                    const float rs = rsv[ai][m];
                    float v[8];
#pragma unroll
                    for (int n = 0; n < 2; ++n)
#pragma unroll
                        for (int j = 0; j < 4; ++j) v[n * 4 + j] = acc[ai][bj][m][n][j] * rs;
                    if (do_gelu) {
#pragma unroll
                        for (int i = 0; i < 8; i += 2) { const f32x2 g = pg8::gelu_pk((f32x2){v[i], v[i + 1]}); v[i] = g.x; v[i + 1] = g.y; }
                    }
                    if (do_rope) {
                        const f32x4 c0 = *(const f32x4*)(cs + (size_t)row * 16 + 8 * (fq & 1)), c1 = *(const f32x4*)(cs + (size_t)row * 16 + 8 * (fq & 1) + 4);
                        const f32x4 s0 = *(const f32x4*)(sn + (size_t)row * 16 + 8 * (fq & 1)), s1 = *(const f32x4*)(sn + (size_t)row * 16 + 8 * (fq & 1) + 4);
                        const float sg = (fq < 2) ? -1.f : 1.f;
#pragma unroll
                        for (int i = 0; i < 8; ++i) {
                            const float pt = __shfl_xor(v[i], 32);
                            const float cc = i < 4 ? c0[i & 3] : c1[i & 3], sv = i < 4 ? s0[i & 3] : s1[i & 3];
                            v[i] = v[i] * cc + sg * pt * sv;
                        }
                    }
                    if (sidx) {
                        float sq = 0.f;
#pragma unroll
                        for (int i = 0; i < 8; ++i) sq += v[i] * v[i];
                        sq += __shfl_xor(sq, 16); sq += __shfl_xor(sq, 32);
                        if (fq == 0) st[(size_t)row * 16 + (u.pn * 2 + bj - sbase) * 4 + wc] = sq;
                    }
                    u32x4 w; w.x = pk_bf16(v[0], v[1]); w.y = pk_bf16(v[2], v[3]); w.z = pk_bf16(v[4], v[5]); w.w = pk_bf16(v[6], v[7]);
                    *(u32x4*)(base + (size_t)row * ldo + col0) = w;
                }
        }
    }
};

struct Job { const float* W; int K, N; bf16_t* dst; const float* gain; int mode; float scale; };
enum { M_PLAIN = 0, M_GATE, M_UP, M_EVENIN, M_Q, M_KV, M_CONVIN };
constexpr float Q_SCALE = 0.10206207261596577f * 1.4426950408889634f;

__device__ __forceinline__ int job_items(int j) {
    if (j < 24) { const int t = j % 6; return (t == 2 || t == 5) ? 44 * 32 : 16 * 88; }
    if (j < 32) { const int t = (j - 24) & 3; return t == 0 ? 16 * 53 : (t == 1 ? 6 * 24 : (t == 2 ? 4 * 32 : 16 * 32)); }
    return ((j - 32) & 1) ? 16 * 32 : 16 * 96;
}
__device__ __forceinline__ Job get_job(const Params& p, int j) {
    Job b; b.scale = 1.f; b.gain = nullptr; b.mode = M_PLAIN;
    unsigned char* ws = p.ws;
    if (j < 24) {
        const int l = j / 6, t = j % 6, post = t >= 3, tt = t % 3;
        const float* nrm = p.in[post ? 7 : 2] + l * DM;
        const float* wg = p.in[post ? 8 : 3] + (size_t)l * DM * FF;
        const float* wu = p.in[post ? 9 : 4] + (size_t)l * DM * FF;
        const float* wd = p.in[post ? 10 : 5] + (size_t)l * DM * FF;
        if (tt == 0) { b.W = wg; b.K = DM; b.N = FF; b.dst = (bf16_t*)(ws + OFF_WGU) + (size_t)(2 * l + post) * NGU * DM; b.gain = nrm; b.mode = M_GATE; }
        else if (tt == 1) { b.W = wu; b.K = DM; b.N = FF; b.dst = (bf16_t*)(ws + OFF_WGU) + (size_t)(2 * l + post) * NGU * DM; b.gain = nrm; b.mode = M_UP; }
        else { b.W = wd; b.K = FF; b.N = DM; b.dst = (bf16_t*)(ws + OFF_WD) + (size_t)(2 * l + post) * DM * FF; }
    } else if (j < 32) {
        const int e = (j - 24) >> 2, t = (j - 24) & 3;
        if (t == 0) { b.W = p.in[11] + (size_t)e * DM * 1696; b.K = DM; b.N = 1696; b.dst = (bf16_t*)(ws + OFF_WIN) + (size_t)e * PW * DM; b.gain = p.in[6] + (2 * e) * DM; b.mode = M_EVENIN; }
        else if (t == 1) { b.W = p.in[13] + (size_t)e * 384 * 768; b.K = 384; b.N = 768; b.dst = (bf16_t*)(ws + OFF_WUQ) + (size_t)e * 768 * 384; b.gain = p.in[12] + e * 384; b.mode = M_Q; b.scale = Q_SCALE; }
        else if (t == 2) { b.W = p.in[15] + (size_t)e * 256 * 1024; b.K = 256; b.N = 1024; b.dst = (bf16_t*)(ws + OFF_WUKV) + (size_t)e * 1024 * 256; b.gain = p.in[14] + e * 256; b.mode = M_KV; }
        else { b.W = p.in[19] + (size_t)e * DM * DM; b.K = DM; b.N = DM; b.dst = (bf16_t*)(ws + OFF_WOUT) + (size_t)e * DM * DM; }
    } else {
        const int o = (j - 32) >> 1, t = (j - 32) & 1;
        if (t == 0) { b.W = p.in[20] + (size_t)o * DM * 3072; b.K = DM; b.N = 3072; b.dst = (bf16_t*)(ws + OFF_WCIN) + (size_t)o * 3072 * DM; b.gain = p.in[6] + (2 * o + 1) * DM; b.mode = M_CONVIN; }
        else { b.W = p.in[22] + (size_t)o * DM * DM; b.K = DM; b.N = DM; b.dst = (bf16_t*)(ws + OFF_WCOUT) + (size_t)o * DM * DM; }
    }
    return b;
}
__device__ __forceinline__ int map_row(int mode, int n) {
    switch (mode) {
        case M_GATE: return 256 * (n >> 7) + (n & 127);
        case M_UP: return 256 * (n >> 7) + 128 + (n & 127);
        case M_EVENIN: return n < 672 ? n : n + 96;
        case M_Q: { const int hd = n / 96, d = n - hd * 96; return d < 64 ? hd * 64 + d : 512 + hd * 32 + (d - 64); }
        case M_KV: { const int hd = n >> 7, d = n & 127; return d < 64 ? hd * 64 + d : 512 + hd * 64 + (d - 64); }
        case M_CONVIN: { if (n < 1024) return 2048 + n; if (n < 2048) { const int jn = n - 1024; return 256 * (jn >> 7) + (jn & 127); } const int jn = n - 2048; return 256 * (jn >> 7) + 128 + (jn & 127); }
        default: return n;
    }
}
__device__ __forceinline__ void transpose_item(const Job& jb, LAS float* scr, int item, int lane) {
    const int nblk = jb.N / 32, kb = item / nblk, nb = item - kb * nblk, k0 = 64 * kb, n0 = 32 * nb;
    const int kr = lane >> 3, c4 = (lane & 7) * 4;
    f32x4 v[8]; float gk[8];
#pragma unroll
    for (int i = 0; i < 8; ++i) {
        const int kk = 8 * i + kr;
        v[i] = *(const f32x4*)(jb.W + (size_t)(k0 + kk) * jb.N + n0 + c4);
        gk[i] = (jb.gain ? jb.gain[k0 + kk] : 1.0f) * jb.scale;
    }
#pragma unroll
    for (int i = 0; i < 8; ++i) {
        const int kk = 8 * i + kr;
        LAS float* d = scr + kk * 33 + c4;
        d[0] = v[i][0] * gk[i]; d[1] = v[i][1] * gk[i]; d[2] = v[i][2] * gk[i]; d[3] = v[i][3] * gk[i];
    }
    asm volatile("s_waitcnt lgkmcnt(0)" ::: "memory");
    const int c = lane & 7, r0 = map_row(jb.mode, n0);
#pragma unroll
    for (int j = 0; j < 4; ++j) {
        const int n = (lane >> 3) + 8 * j; const LAS float* s = scr + (8 * c) * 33 + n;
        u32x4 o; o.x = pk_bf16(s[0 * 33], s[1 * 33]); o.y = pk_bf16(s[2 * 33], s[3 * 33]); o.z = pk_bf16(s[4 * 33], s[5 * 33]); o.w = pk_bf16(s[6 * 33], s[7 * 33]);
        *(u32x4*)(jb.dst + (size_t)(r0 + n) * jb.K + k0 + 8 * c) = o;
    }
    asm volatile("s_waitcnt lgkmcnt(0)" ::: "memory");
}

__device__ __forceinline__ void convert_jobs(const Params& p, LAS unsigned char* lds, int j_lo, int j_hi, int w, int nw, int lane, int wave) {
    LAS float* scr = (LAS float*)(lds + wave * 8704);
    int total = 0;
    for (int j = j_lo; j < j_hi; ++j) total += job_items(j);
    for (int it = w; it < total; it += nw) {
        int r = it, j = j_lo;
        for (; j < j_hi; ++j) { const int c = job_items(j); if (r < c) break; r -= c; }
        const Job jb = get_job(p, j);
        transpose_item(jb, scr, r, lane);
    }
}
__device__ __forceinline__ void prologue(const Params& p, LAS unsigned char* lds, int gw, int ngw, int lane, int wave) {
    unsigned char* ws = p.ws;
    {
        float* cs = (float*)(ws + OFF_ROPE); float* sn = cs + S * 16;
        const int* pos = (const int*)p.in[1];
        for (int idx = gw * 64 + lane; idx < S * 16; idx += ngw * 64) {
            const int t = idx >> 4, i = idx & 15;
            const float ang = (float)pos[t] * p.inv_freq[i];
            const double a = (double)ang;
            const double k = rint(a * 0.15915494309189535);
            const double r = a - k * 6.283185307179586;
            const double r2 = r * r;
            double ts = r, ssum = r, tc = 1.0, csum = 1.0;
#pragma unroll 1
            for (int q = 1; q <= 15; ++q) {
                tc *= -r2 / (double)((2 * q - 1) * (2 * q)); csum += tc;
                ts *= -r2 / (double)((2 * q) * (2 * q + 1)); ssum += ts;
            }
            cs[idx] = (float)csum; sn[idx] = (float)ssum;
        }
    }
    {
        const float* x = p.in[0]; bf16_t* XB = (bf16_t*)(ws + OFF_XB); float* ss0 = (float*)(ws + OFF_SS);
        for (int row = gw; row < S; row += ngw) {
            const f32x4* xr = (const f32x4*)(x + (size_t)row * DM) + lane;
            float s = 0.f;
#pragma unroll
            for (int j = 0; j < 4; ++j) {
                const f32x4 v = xr[64 * j];
                u32x2 w; w.x = pk_bf16(v[0], v[1]); w.y = pk_bf16(v[2], v[3]);
                ((u32x2*)(XB + (size_t)row * DM) + lane)[64 * j] = w;
                const float a = __uint_as_float(w.x << 16), b = __uint_as_float(w.x & 0xffff0000u), c = __uint_as_float(w.y << 16), d = __uint_as_float(w.y & 0xffff0000u);
                s += (a * a + b * b) + (c * c + d * d);
            }
#pragma unroll
            for (int o = 1; o < 64; o <<= 1) s += __shfl_xor(s, o);
            if (lane < 16) ss0[(size_t)row * 16 + lane] = (lane == 0) ? s : 0.f;
        }
    }
    {
        const float* sw = p.in[17]; unsigned* wo = (unsigned*)(ws + OFF_WSG);
        for (int i = gw * 64 + lane; i < 2 * 8 * 128 * 64; i += ngw * 64) {
            const int tt = (i >> 6) & 127, s2 = (i & 63) * 2;
            const f32x2 v = *(const f32x2*)(sw + (size_t)i * 2);
            wo[i] = pk_bf16(s2 <= tt ? v[0] : 0.f, s2 + 1 <= tt ? v[1] : 0.f);
        }
    }
    for (int e = 0; e < 2; ++e) {
        u32x4* z = (u32x4*)((bf16_t*)(ws + OFF_WIN) + (size_t)e * PW * DM + (size_t)672 * DM);
        for (int idx = gw * 64 + lane; idx < 96 * DM / 8; idx += ngw * 64) z[idx] = (u32x4){0u, 0u, 0u, 0u};
    }
    convert_jobs(p, lds, 0, 3, gw, ngw, lane, wave);
}

__device__ __forceinline__ void sgu_unit(LAS unsigned char* lds, int unit, const bf16_t* __restrict__ P, const float* __restrict__ ssv,
                                         const bf16_t* __restrict__ wsg, const float* __restrict__ sgb, const float* __restrict__ sgn, bf16_t* __restrict__ MIX) {
    int tid_l = threadIdx.x; asm volatile("" : "+v"(tid_l)); const int tid = tid_l, lane = tid & 63, wid = __builtin_amdgcn_readfirstlane(tid >> 6), r32 = lane & 31, hi = lane >> 5;
    const int chunk = unit >> 1, hf = unit & 1, s0 = chunk * 128;
    LAS float* rv = (LAS float*)lds;
    LAS unsigned short* vT = (LAS unsigned short*)(lds + 1024);
    u32x4 d[8];
#pragma unroll
    for (int i = 0; i < 8; ++i) { const int c = tid + 512 * i, srow = c & 127, part = c >> 7; d[i] = *(const u32x4*)(P + (size_t)(s0 + srow) * PW + P_V + hf * 256 + part * 8); }
    if (tid < 128) rv[tid] = rsqrtf(row_ss(ssv, s0 + tid, 16) * (1.0f / 512.0f) + EPS);
    const int gl = wid & 3, rh = wid >> 2, g = 4 * hf + gl;
    bf16x8 af[2][8];
#pragma unroll
    for (int mt = 0; mt < 2; ++mt)
#pragma unroll
        for (int ks = 0; ks < 8; ++ks) af[mt][ks] = *(const bf16x8*)(wsg + ((size_t)g * 128 + 64 * rh + 32 * mt + r32) * 128 + 16 * ks + 8 * hi);
    u32x2 uu[2][2][4];
#pragma unroll
    for (int mt = 0; mt < 2; ++mt)
#pragma unroll
        for (int nt = 0; nt < 2; ++nt)
#pragma unroll
            for (int rg = 0; rg < 4; ++rg) uu[mt][nt][rg] = *(const u32x2*)(P + (size_t)(s0 + 64 * rh + 32 * mt + r32) * PW + P_U + g * 64 + 32 * nt + 8 * rg + 4 * hi);
    f32x4 gnv[2][4]; float biasv[2];
#pragma unroll
    for (int nt = 0; nt < 2; ++nt)
#pragma unroll
        for (int rg = 0; rg < 4; ++rg) gnv[nt][rg] = *(const f32x4*)(sgn + g * 64 + 32 * nt + 8 * rg + 4 * hi);
#pragma unroll
    for (int mt = 0; mt < 2; ++mt) biasv[mt] = sgb[g * 128 + 64 * rh + 32 * mt + r32];
    __syncthreads();
#pragma unroll
    for (int i = 0; i < 8; ++i) {
        const int c = tid + 512 * i, srow = c & 127, part = c >> 7;
        const float r = rv[srow];
        LAS unsigned short* dst = vT + (size_t)(part * 8) * 136 + srow;
#pragma unroll
        for (int q = 0; q < 4; ++q) {
            const unsigned pk = pk_bf16(__uint_as_float(d[i][q] << 16) * r, __uint_as_float(d[i][q] & 0xffff0000u) * r);
            dst[(2 * q) * 136] = (unsigned short)(pk & 0xffffu); dst[(2 * q + 1) * 136] = (unsigned short)(pk >> 16);
        }
    }
    __syncthreads();
    f32x16 acc[2][2];
#pragma unroll
    for (int a = 0; a < 2; ++a)
#pragma unroll
        for (int b = 0; b < 2; ++b)
#pragma unroll
            for (int r = 0; r < 16; ++r) acc[a][b][r] = 0.f;
#pragma unroll
    for (int mt = 0; mt < 2; ++mt)
#pragma unroll
        for (int ks = 0; ks < 8; ++ks)
#pragma unroll
            for (int nt = 0; nt < 2; ++nt) {
                const bf16x8 bfr = *(const LAS bf16x8*)(vT + (size_t)(gl * 64 + 32 * nt + r32) * 136 + 16 * ks + 8 * hi);
                acc[mt][nt] = __builtin_amdgcn_mfma_f32_32x32x16_bf16(bfr, af[mt][ks], acc[mt][nt], 0, 0, 0);
            }
#pragma unroll
    for (int mt = 0; mt < 2; ++mt) {
        const int tt = 64 * rh + 32 * mt + r32;
        const float bias = biasv[mt];
#pragma unroll
        for (int nt = 0; nt < 2; ++nt)
#pragma unroll
            for (int rg = 0; rg < 4; ++rg) {
                const int col = g * 64 + 32 * nt + 8 * rg + 4 * hi;
                const f32x4 gn = gnv[nt][rg];
                const u32x2 uv = uu[mt][nt][rg];
                const float o0 = __uint_as_float(uv.x << 16) * (gn[0] * acc[mt][nt][4 * rg + 0] + bias);
                const float o1 = __uint_as_float(uv.x & 0xffff0000u) * (gn[1] * acc[mt][nt][4 * rg + 1] + bias);
                const float o2 = __uint_as_float(uv.y << 16) * (gn[2] * acc[mt][nt][4 * rg + 2] + bias);
                const float o3 = __uint_as_float(uv.y & 0xffff0000u) * (gn[3] * acc[mt][nt][4 * rg + 3] + bias);
                u32x2 w; w.x = pk_bf16(o0, o1); w.y = pk_bf16(o2, o3);
                *(u32x2*)(MIX + (size_t)(s0 + tt) * DM + 512 + col) = w;
            }
    }
    __syncthreads();
}

constexpr int AT_KSTR = 208, AT_VSTR = 192, AT_KB = 64 * AT_KSTR, AT_VB = 64 * AT_VSTR;
constexpr float ATT_THR = 8.0f;
#define MX3(a, b, c) __builtin_fmaxf(__builtin_fmaxf((a), (b)), (c))
typedef __bf16 bf16x2_t __attribute__((ext_vector_type(2)));
__device__ __forceinline__ unsigned pk2(float lo, float hi) { f32x2 v = {lo, hi}; bf16x2_t b = __builtin_convertvector(v, bf16x2_t); return __builtin_bit_cast(unsigned, b); }
__device__ __forceinline__ float rowmax32(const f32x16& a, const f32x16& b) {
    float x = MX3(a[0], a[1], b[0]), y = MX3(a[2], a[3], b[1]); x = MX3(x, b[2], b[3]);
#pragma unroll
    for (int r = 4; r < 16; r += 4) { x = MX3(x, a[r], a[r + 1]); y = MX3(y, a[r + 2], a[r + 3]); x = MX3(x, b[r], b[r + 1]); y = MX3(y, b[r + 2], b[r + 3]); }
    return swap32_max(__builtin_fmaxf(x, y));
}
__device__ __forceinline__ void attn_kload(bf16x8 (&kf)[12], const LAS unsigned char* Ks, int r32, int hi) {
#pragma unroll
    for (int d0 = 0; d0 < 6; ++d0) {
        kf[2 * d0] = *(const LAS bf16x8*)(Ks + r32 * AT_KSTR + d0 * 32 + hi * 16);
        kf[2 * d0 + 1] = *(const LAS bf16x8*)(Ks + (32 + r32) * AT_KSTR + d0 * 32 + hi * 16);
    }
}
__device__ __forceinline__ void attn_qk(f32x16& s0, f32x16& s1, const bf16x8 (&kf)[12], const bf16x8 (&qf)[6], const f32x16& negm) {
#pragma unroll
    for (int d0 = 0; d0 < 6; ++d0) {
        if (d0 == 0) { s0 = __builtin_amdgcn_mfma_f32_32x32x16_bf16(kf[0], qf[0], negm, 0, 0, 0); s1 = __builtin_amdgcn_mfma_f32_32x32x16_bf16(kf[1], qf[0], negm, 0, 0, 0); }
        else { s0 = __builtin_amdgcn_mfma_f32_32x32x16_bf16(kf[2 * d0], qf[d0], s0, 0, 0, 0); s1 = __builtin_amdgcn_mfma_f32_32x32x16_bf16(kf[2 * d0 + 1], qf[d0], s1, 0, 0, 0); }
    }
}
__device__ __forceinline__ void attn_mask(f32x16& s0, f32x16& s1, int jb, int qrel, int hi) {
#pragma unroll
    for (int r = 0; r < 16; ++r) {
        const int kv = 64 * jb + crow(r, hi);
        if (kv > qrel) s0[r] = -INFINITY;
        if (kv + 32 > qrel) s1[r] = -INFINITY;
    }
}
__device__ __forceinline__ void attn_unit(LAS unsigned char* lds, const bf16_t* __restrict__ Qb, const bf16_t* __restrict__ KN, const bf16_t* __restrict__ Pb,
                                          const bf16_t* __restrict__ Vb, bf16_t* __restrict__ MIX, int h, int qb) {
    int tid_l = threadIdx.x; asm volatile("" : "+v"(tid_l)); const int tid = tid_l, lane = tid & 63, wid = __builtin_amdgcn_readfirstlane(tid >> 6), r32 = lane & 31, hi = lane >> 5;
    const int qrow = qb * 256 + wid * 32 + r32, qrel = 32 * wid + r32;
    bf16x8 qf[6];
    {
        const bf16_t* qp = Qb + (size_t)qrow * QW;
#pragma unroll
        for (int d0 = 0; d0 < 4; ++d0) qf[d0] = *(const bf16x8*)(qp + h * 64 + d0 * 16 + hi * 8);
#pragma unroll
        for (int d0 = 4; d0 < 6; ++d0) qf[d0] = *(const bf16x8*)(qp + 512 + h * 32 + (d0 - 4) * 16 + hi * 8);
    }
    const int NT = 4 * qb + 4;
    const int ra = tid / 12, pa = tid - ra * 12;
    const int cb = 512 + tid, rb = cb / 12, pb = cb - rb * 12;
    const bf16_t* srcA = pa < 8 ? KN + (size_t)ra * 512 + h * 64 + pa * 8 : Pb + (size_t)ra * PW + P_KR + (pa - 8) * 8;
    const size_t strA = pa < 8 ? (size_t)64 * 512 : (size_t)64 * PW;
    const bf16_t* srcB = pb < 8 ? KN + (size_t)rb * 512 + h * 64 + pb * 8 : Pb + (size_t)rb * PW + P_KR + (pb - 8) * 8;
    const size_t strB = pb < 8 ? (size_t)64 * 512 : (size_t)64 * PW;
    const bf16_t* srcV = Vb + (size_t)(tid >> 3) * 512 + h * 64 + (tid & 7) * 8;
    const int dstA = ra * AT_KSTR + pa * 16, dstB = rb * AT_KSTR + pb * 16, dstV = 2 * AT_KB + (tid >> 3) * AT_VSTR + (tid & 7) * 16;
    const bool hasB = tid < 256;
    u32x4 ga, gb = (u32x4){0u, 0u, 0u, 0u}, gv;
    ga = *(const u32x4*)srcA; gv = *(const u32x4*)srcV; if (hasB) gb = *(const u32x4*)srcB;
    *(LAS u32x4*)(lds + dstA) = ga; *(LAS u32x4*)(lds + dstV) = gv; if (hasB) *(LAS u32x4*)(lds + dstB) = gb;
    ga = *(const u32x4*)(srcA + strA); if (hasB) gb = *(const u32x4*)(srcB + strB);
    *(LAS u32x4*)(lds + AT_KB + dstA) = ga; if (hasB) *(LAS u32x4*)(lds + AT_KB + dstB) = gb;
    __syncthreads();
    float mref = 0.f, lrun = 0.f, mxc;
    f32x16 o0, o1, negm, sA0, sA1, sB0, sB1;
#pragma unroll
    for (int r = 0; r < 16; ++r) { o0[r] = 0.f; o1[r] = 0.f; negm[r] = 0.f; }
    const int i16 = lane & 15, vq = i16 >> 2, vp = i16 & 3, vblk = (lane >> 4) & 1;
    const int voff = 2 * AT_KB + (4 * hi + vq) * AT_VSTR + vblk * 32 + vp * 8;
    { bf16x8 kf0[12]; attn_kload(kf0, lds, r32, hi); attn_qk(sA0, sA1, kf0, qf, negm); }
    if (qb == 0) attn_mask(sA0, sA1, 0, qrel, hi);
    mref = rowmax32(sA0, sA1);
#pragma unroll
    for (int r = 0; r < 16; ++r) { sA0[r] -= mref; sA1[r] -= mref; negm[r] = -mref; }
    mxc = 0.f;
#define ATT_STEP(C0, C1, N0, N1, T) do { \
        const int t_ = (T); const bool more1 = (t_ + 1 < NT), more2 = (t_ + 2 < NT); \
        if (more2) { ga = *(const u32x4*)(srcA + (size_t)(t_ + 2) * strA); if (hasB) gb = *(const u32x4*)(srcB + (size_t)(t_ + 2) * strB); } \
        if (more1) gv = *(const u32x4*)(srcV + (size_t)(t_ + 1) * 64 * 512); \
        if (__any(mxc > ATT_THR)) { \
            const float dl = fmaxf(mxc, 0.f); mref += dl; const float al = __builtin_amdgcn_exp2f(-dl); lrun *= al; \
            _Pragma("unroll") for (int r = 0; r < 16; ++r) { C0[r] -= dl; C1[r] -= dl; negm[r] = -mref; o0[r] *= al; o1[r] *= al; } \
        } \
        const LAS unsigned char* Kn = lds + ((t_ + 1) & 1) * AT_KB; \
        bf16x8 kf[12]; attn_kload(kf, Kn, r32, hi); \
        __builtin_amdgcn_sched_barrier(0); \
        attn_qk(N0, N1, kf, qf, negm); \
        float ps0 = 0.f, ps1 = 0.f, ps2 = 0.f, ps3 = 0.f; \
        _Pragma("unroll") for (int r = 0; r < 16; r += 2) { C0[r] = __builtin_amdgcn_exp2f(C0[r]); C1[r] = __builtin_amdgcn_exp2f(C1[r]); C0[r + 1] = __builtin_amdgcn_exp2f(C0[r + 1]); C1[r + 1] = __builtin_amdgcn_exp2f(C1[r + 1]); \
            ps0 += C0[r]; ps1 += C1[r]; ps2 += C0[r + 1]; ps3 += C1[r + 1]; } \
        lrun += (ps0 + ps1) + (ps2 + ps3); \
        bf16x8 pf[4]; \
        _Pragma("unroll") for (int ks = 0; ks < 2; ++ks) { \
            u32x4 w0, w1; \
            w0.x = pk2(C0[8 * ks + 0], C0[8 * ks + 1]); w0.y = pk2(C0[8 * ks + 2], C0[8 * ks + 3]); w0.z = pk2(C0[8 * ks + 4], C0[8 * ks + 5]); w0.w = pk2(C0[8 * ks + 6], C0[8 * ks + 7]); \
            w1.x = pk2(C1[8 * ks + 0], C1[8 * ks + 1]); w1.y = pk2(C1[8 * ks + 2], C1[8 * ks + 3]); w1.z = pk2(C1[8 * ks + 4], C1[8 * ks + 5]); w1.w = pk2(C1[8 * ks + 6], C1[8 * ks + 7]); \
            asm volatile("" : "+v"(w0), "+v"(w1)); \
            pf[ks] = __builtin_bit_cast(bf16x8, w0); pf[2 + ks] = __builtin_bit_cast(bf16x8, w1); } \
        asm volatile("" : "+v"(lrun)); \
        _Pragma("unroll") for (int i_ = 0; i_ < 12; ++i_) { __builtin_amdgcn_sched_group_barrier(0x008, 1, 0); __builtin_amdgcn_sched_group_barrier(0x002, 7, 0); } \
        __builtin_amdgcn_sched_barrier(0); \
        const LAS unsigned char* Vs = lds + voff + (t_ & 1) * AT_VB; \
        s16x4 vlo[8], vhi[8]; \
        _Pragma("unroll") for (int ks = 0; ks < 4; ++ks) { \
            _Pragma("unroll") for (int db = 0; db < 2; ++db) { \
                const LAS unsigned char* vp0 = Vs + ks * 16 * AT_VSTR + db * 64; \
                vlo[ks * 2 + db] = __builtin_bit_cast(s16x4, __builtin_amdgcn_ds_read_tr16_b64_v4i16((LAS s16x4*)vp0)); \
                vhi[ks * 2 + db] = __builtin_bit_cast(s16x4, __builtin_amdgcn_ds_read_tr16_b64_v4i16((LAS s16x4*)(vp0 + 8 * AT_VSTR))); } } \
        if (t_ + 1 >= 4 * qb) attn_mask(N0, N1, t_ + 1 - 4 * qb, qrel, hi); \
        __builtin_amdgcn_sched_barrier(0); \
        _Pragma("unroll") for (int ks = 0; ks < 4; ++ks) { \
            _Pragma("unroll") for (int db = 0; db < 2; ++db) { \
                const s16x4 lo = vlo[ks * 2 + db], hh = vhi[ks * 2 + db]; \
                const bf16x8 vf = (bf16x8){lo[0], lo[1], lo[2], lo[3], hh[0], hh[1], hh[2], hh[3]}; \
                if (db == 0) o0 = __builtin_amdgcn_mfma_f32_32x32x16_bf16(vf, pf[ks], o0, 0, 0, 0); \
                else o1 = __builtin_amdgcn_mfma_f32_32x32x16_bf16(vf, pf[ks], o1, 0, 0, 0); } } \
        mxc = rowmax32(N0, N1); \
        _Pragma("unroll") for (int i_ = 0; i_ < 8; ++i_) { __builtin_amdgcn_sched_group_barrier(0x008, 1, 1); __builtin_amdgcn_sched_group_barrier(0x002, 3, 1); } \
        __builtin_amdgcn_sched_barrier(0); \
        if (more2) { LAS unsigned char* kd = lds + (t_ & 1) * AT_KB; *(LAS u32x4*)(kd + dstA) = ga; if (hasB) *(LAS u32x4*)(kd + dstB) = gb; } \
        if (more1) *(LAS u32x4*)(lds + ((t_ + 1) & 1) * AT_VB + dstV) = gv; \
        __syncthreads(); \
    } while (0)
    for (int t = 0; t < NT; t += 2) {
        ATT_STEP(sA0, sA1, sB0, sB1, t);
        ATT_STEP(sB0, sB1, sA0, sA1, t + 1);
    }
#undef ATT_STEP
    const float inv = 1.0f / swap32_sum(lrun);
    bf16_t* op = MIX + (size_t)qrow * DM + h * 64 + 4 * hi;
#pragma unroll
    for (int rg = 0; rg < 4; ++rg) {
        u32x2 w0, w1;
        w0.x = pk_bf16(o0[4 * rg] * inv, o0[4 * rg + 1] * inv); w0.y = pk_bf16(o0[4 * rg + 2] * inv, o0[4 * rg + 3] * inv);
        w1.x = pk_bf16(o1[4 * rg] * inv, o1[4 * rg + 1] * inv); w1.y = pk_bf16(o1[4 * rg + 2] * inv, o1[4 * rg + 3] * inv);
        *(u32x2*)(op + 8 * rg) = w0; *(u32x2*)(op + 32 + 8 * rg) = w1;
    }
}

__global__ void __launch_bounds__(NTHREADS, 2) mega_fwd(Params p) {
    extern __shared__ __attribute__((aligned(16))) unsigned char lds_raw[];
    LAS unsigned char* lds = (LAS unsigned char*)lds_raw;
    cg::grid_group grid = cg::this_grid();
    const int G = gridDim.x, bid = blockIdx.x;
    const int ngw = G * NWAVES;
#define LAUNDER_TID() int tid_l = threadIdx.x; asm volatile("" : "+v"(tid_l)); const int tid = tid_l, lane = tid & 63, wave = __builtin_amdgcn_readfirstlane(tid >> 6), gw = bid * NWAVES + wave; (void)tid; (void)lane; (void)gw;
    unsigned char* ws = p.ws;
    float* ssb = (float*)(ws + OFF_SS);
    bf16_t* XB = (bf16_t*)(ws + OFF_XB);
    const float* cs = (const float*)(ws + OFF_ROPE); const float* sn = cs + S * 16;
    int st = 0;
    const int lo = p.step_lo, hi_ = p.step_hi;
    const bool single = (lo == 0 && hi_ >= 1000);
#define RUN (st >= lo && st < hi_)
#define SYNC() do { if (single) xcd_barrier(xbar); ++st; } while (0)

    volatile LAS unsigned* xst = (volatile LAS unsigned*)(lds + LDS_MISC);
    if (threadIdx.x < 2) xst[threadIdx.x] = 0u;
    __syncthreads();
    XcdBarrier xbar; xbar.bar = (unsigned*)(ws + OFF_BAR); xbar.x = 0; xbar.st = xst;
    if (single) xbar = xcd_barrier_post((unsigned*)(ws + OFF_BAR), xst);
    if (p.step_hi < 0) grid.sync();
    if (RUN) { LAUNDER_TID(); prologue(p, lds, gw, ngw, lane, wave); }
    if (single) xcd_barrier(xbar);
    ++st;

    for (int l = 0; l < 4; ++l) {
        for (int sub = 0; sub < 3; ++sub) {
            const bool is_ffn = (sub != 1), even = ((l & 1) == 0);
            const int e = l >> 1;
            const int kin = l * 3 + sub;
            float* ss_in = ssb + (size_t)kin * S * 16; float* ss_out = ssb + (size_t)(kin + 1) * S * 16;
            float* ss_cq = ssb + (size_t)(13 + 3 * e) * S * 16; float* ss_ckv = ss_cq + (size_t)S * 16; float* ss_v = ss_ckv + (size_t)S * 16;
            if (is_ffn || !even) {
                if (RUN) {
                    pg8::Gemm g; pg8::StaticOrder So; EpiPair E;
                    g.A = XB; g.M = S; g.K = DM; g.lda = DM; g.ldb = DM;
                    if (is_ffn) { g.Bt = (const bf16_t*)(ws + OFF_WGU) + (size_t)(2 * l + (sub == 2)) * NGU * DM; g.N = NGU; E.O = (bf16_t*)(ws + OFF_ACT); E.ldo = FF; E.mode = 0; }
                    else { g.Bt = (const bf16_t*)(ws + OFF_WCIN) + (size_t)e * 3072 * DM; g.N = 2048; E.O = (bf16_t*)(ws + OFF_CZ); E.ldo = DM; E.mode = 1; }
                    E.ss = ss_in; E.inv_dim = 1.0f / DM;
                    So.init(S, g.N, G, bid);
                    pg8::gemm_phase<EpiPair, pg8::StaticOrder, true, true>(lds, g, So, E);
                    if (is_ffn) {
                        const int nfull = (64 * 22) % G, nwk = nfull ? G - nfull : G, wk = nfull ? bid - nfull : bid;
                        if (wk >= 0) {
                            LAUNDER_TID();
                            int a0, a1, b0 = 0, b1 = 0;
                            if (sub == 0) { a0 = 6 * l + 3; a1 = 6 * l + 6; if (l == 0) { b0 = 24; b1 = 28; } }
                            else if (l < 3) { const int ln = l + 1; a0 = 6 * ln; a1 = 6 * ln + 3; if (ln & 1) { b0 = 32 + 2 * (ln >> 1); b1 = b0 + 2; } else { b0 = 24 + 4 * (ln >> 1); b1 = b0 + 4; } }
                            else { a0 = 0; a1 = 0; }
                            convert_jobs(p, lds, a0, a1, wk * NWAVES + wave, nwk * NWAVES, lane, wave);
                            convert_jobs(p, lds, b0, b1, wk * NWAVES + wave, nwk * NWAVES, lane, wave);
                        }
                    }
                }
            }
            if (!is_ffn) {
                const int ng = even ? 3 : 1;
                for (int gi = 0; gi < ng; ++gi) {
                    if (RUN) {
                        pg8::Gemm g; pg8::StaticOrder So; EpiRow E;
                        g.M = S; E.split_tiles = 0; E.split_stride = 0; E.gelu_from = 1 << 20; E.rope_pn = -1; E.rope_bj = -1; E.rope_wc = 0; E.cs = cs; E.sn = sn;
                        E.stat_map = 0ull; E.stb = ss_cq;
                        if (!even) {
                            g.A = XB; g.lda = DM; g.K = DM; g.ldb = DM; g.Bt = (const bf16_t*)(ws + OFF_WCIN) + (size_t)e * 3072 * DM + (size_t)2048 * DM; g.N = 1024;
                            E.O = (bf16_t*)(ws + OFF_BG); E.ldo = DM; E.ss = ss_in; E.inv_dim = 1.0f / DM; E.nsl = 16;
                        } else if (gi == 0) {
                            g.A = XB; g.lda = DM; g.K = DM; g.ldb = DM; g.Bt = (const bf16_t*)(ws + OFF_WIN) + (size_t)e * PW * DM; g.N = PW;
                            E.O = (bf16_t*)(ws + OFF_P); E.ldo = PW; E.ss = ss_in; E.inv_dim = 1.0f / DM; E.nsl = 16;
                            E.gelu_from = 3; E.rope_pn = 2; E.rope_bj = 1; E.rope_wc = 0;
                            E.stat_map = 0x1ull | (0x1ull << 4) | (0x1ull << 8) | (0x2ull << 12) | (0x2ull << 16) | (0x3ull << 40) | (0x3ull << 44) | (0x3ull << 48) | (0x3ull << 52);
                        } else if (gi == 1) {
                            g.A = (const bf16_t*)(ws + OFF_P) + P_CKV; g.lda = PW; g.K = 256; g.ldb = 256; g.Bt = (const bf16_t*)(ws + OFF_WUKV) + (size_t)e * 1024 * 256; g.N = 1024;
                            E.O = (bf16_t*)(ws + OFF_KN); E.ldo = 512; E.split_tiles = 2; E.split_stride = (OFF_V - OFF_KN) / 2; E.ss = ss_ckv; E.inv_dim = 1.0f / 256.0f; E.nsl = 8;
                        } else {
                            g.A = (const bf16_t*)(ws + OFF_P) + P_CQ; g.lda = PW; g.K = 384; g.ldb = 384; g.Bt = (const bf16_t*)(ws + OFF_WUQ) + (size_t)e * 768 * 384; g.N = 768;
                            E.O = (bf16_t*)(ws + OFF_Q); E.ldo = QW; E.ss = ss_cq; E.inv_dim = 1.0f / 384.0f; E.nsl = 12; E.rope_pn = 2; E.rope_bj = -1;
                        }
                        So.init(S, g.N, G, bid);
                        pg8::gemm_phase<EpiRow, pg8::StaticOrder, true, true>(lds, g, So, E);
                    }
                    if (even && gi == 0) SYNC();
                }
            }
            SYNC();
            if (!is_ffn) {
                if (RUN) {
                    if (even) {
                        const bf16_t* P = (const bf16_t*)(ws + OFF_P);
                        bf16_t* MIX = (bf16_t*)(ws + OFF_MIX);
                        for (int u = bid; u < 256; u += G)
                            sgu_unit(lds, u, P, ss_v, (const bf16_t*)(ws + OFF_WSG) + (size_t)e * 8 * 128 * 128, p.in[18] + (size_t)e * 8 * 128, p.in[16] + (size_t)e * 512, MIX);
                        for (int u = bid; u < 256; u += G) {
                            const int h = u & 7, s = u >> 3;
                            attn_unit(lds, (const bf16_t*)(ws + OFF_Q), (const bf16_t*)(ws + OFF_KN), P, (const bf16_t*)(ws + OFF_V), MIX, h, 63 - s);
                            attn_unit(lds, (const bf16_t*)(ws + OFF_Q), (const bf16_t*)(ws + OFF_KN), P, (const bf16_t*)(ws + OFF_V), MIX, h, s);
                        }
                    } else {
                        const bf16_t* CZ = (const bf16_t*)(ws + OFF_CZ); const bf16_t* BG = (const bf16_t*)(ws + OFF_BG); bf16_t* Gb = (bf16_t*)(ws + OFF_G);
                        const float* cw = p.in[21] + (size_t)e * 3 * DM;
                        LAUNDER_TID();
                        for (int idx = bid * NTHREADS + tid; idx < S * 128; idx += G * NTHREADS) {
                            const int t = idx >> 7, c8 = (idx & 127) * 8;
                            const u32x4 z0 = *(const u32x4*)(CZ + (size_t)t * DM + c8);
                            const u32x4 z1 = t >= 1 ? *(const u32x4*)(CZ + (size_t)(t - 1) * DM + c8) : (u32x4){0u, 0u, 0u, 0u};
                            const u32x4 z2 = t >= 2 ? *(const u32x4*)(CZ + (size_t)(t - 2) * DM + c8) : (u32x4){0u, 0u, 0u, 0u};
                            const u32x4 bg = *(const u32x4*)(BG + (size_t)t * DM + c8);
                            float o[8];
#pragma unroll
                            for (int i = 0; i < 4; ++i) {
#pragma unroll
                                for (int hlf = 0; hlf < 2; ++hlf) {
                                    const int c = c8 + 2 * i + hlf;
                                    const float a0 = hlf ? __uint_as_float(z0[i] & 0xffff0000u) : __uint_as_float(z0[i] << 16);
                                    const float a1 = hlf ? __uint_as_float(z1[i] & 0xffff0000u) : __uint_as_float(z1[i] << 16);
                                    const float a2 = hlf ? __uint_as_float(z2[i] & 0xffff0000u) : __uint_as_float(z2[i] << 16);
                                    const float bb = hlf ? __uint_as_float(bg[i] & 0xffff0000u) : __uint_as_float(bg[i] << 16);
                                    o[2 * i + hlf] = bb * (cw[c] * a2 + cw[DM + c] * a1 + cw[2 * DM + c] * a0);
                                }
                            }
                            u32x4 w; w.x = pk_bf16(o[0], o[1]); w.y = pk_bf16(o[2], o[3]); w.z = pk_bf16(o[4], o[5]); w.w = pk_bf16(o[6], o[7]);
                            *(u32x4*)(Gb + (size_t)t * DM + c8) = w;
                        }
                    }
                }
                SYNC();
            }
            if (RUN) {
                pg8::Gemm g; pg8::StaticOrder So; EpiRes E;
                g.M = S; g.N = DM;
                if (is_ffn) { g.A = (const bf16_t*)(ws + OFF_ACT); g.K = FF; g.lda = FF; g.ldb = FF; g.Bt = (const bf16_t*)(ws + OFF_WD) + (size_t)(2 * l + (sub == 2)) * DM * FF; E.alpha = 0.5f; }
                else if (even) { g.A = (const bf16_t*)(ws + OFF_MIX); g.K = DM; g.lda = DM; g.ldb = DM; g.Bt = (const bf16_t*)(ws + OFF_WOUT) + (size_t)e * DM * DM; E.alpha = 1.0f; }
                else { g.A = (const bf16_t*)(ws + OFF_G); g.K = DM; g.lda = DM; g.ldb = DM; g.Bt = (const bf16_t*)(ws + OFF_WCOUT) + (size_t)e * DM * DM; E.alpha = 1.0f; }
                E.XB = XB; E.ss_out = ss_out;
                So.init(S, DM, G, bid);
                pg8::gemm_phase<EpiRes, pg8::StaticOrder, true, true>(lds, g, So, E);
            }
            SYNC();
        }
    }
    if (RUN) {
        const float* gn = p.in[23];
        LAUNDER_TID();
        for (int row = gw; row < S; row += ngw) {
            const u32x2* xr = (const u32x2*)(XB + (size_t)row * DM) + lane;
            f32x4 v[4]; float s = 0.f;
#pragma unroll
            for (int j = 0; j < 4; ++j) {
                const u32x2 w = xr[64 * j];
                v[j] = (f32x4){__uint_as_float(w.x << 16), __uint_as_float(w.x & 0xffff0000u), __uint_as_float(w.y << 16), __uint_as_float(w.y & 0xffff0000u)};
                s += (v[j][0] * v[j][0] + v[j][1] * v[j][1]) + (v[j][2] * v[j][2] + v[j][3] * v[j][3]);
            }
#pragma unroll
            for (int o = 1; o < 64; o <<= 1) s += __shfl_xor(s, o);
            const float rs = rsqrtf(s * (1.0f / DM) + EPS);
            f32x4* orow = (f32x4*)(p.out + (size_t)row * DM) + lane;
#pragma unroll
            for (int j = 0; j < 4; ++j) { const f32x4 gg = ((const f32x4*)gn + lane)[64 * j]; orow[64 * j] = v[j] * rs * gg; }
        }
    }
#undef RUN
#undef SYNC
}

#ifndef MK_MULTI
#define MK_MULTI 0
#endif
extern "C" void kernel_launch(void* const* d_in, const int* in_sizes, int n_in, void* d_out, int out_size, void* d_ws, size_t ws_size, hipStream_t stream) {
    static int grid = 0;
    if (grid == 0) {
        if (n_in != 24 || out_size != S * DM || ws_size < WS_END) { fprintf(stderr, "kernel_launch: unexpected problem (n_in %d out %d ws %zu)\n", n_in, out_size, ws_size); grid = -1; return; }
        int dev = 0, cus = 0, per_cu = 0;
        hipGetDevice(&dev);
        hipDeviceGetAttribute(&cus, hipDeviceAttributeMultiprocessorCount, dev);
        if (hipFuncSetAttribute((const void*)mega_fwd, hipFuncAttributeMaxDynamicSharedMemorySize, LDS_BYTES) != hipSuccess) { fprintf(stderr, "hipFuncSetAttribute failed\n"); grid = -1; return; }
        if (hipOccupancyMaxActiveBlocksPerMultiprocessor(&per_cu, (const void*)mega_fwd, NTHREADS, LDS_BYTES) != hipSuccess || per_cu < 1) { fprintf(stderr, "occupancy query failed (%d)\n", per_cu); per_cu = 1; }
        (void)hipGetLastError();
        if (per_cu > 1) per_cu = 1;
        grid = cus * per_cu;
    }
    if (grid < 0) return;
    (void)hipMemsetAsync((char*)d_ws + OFF_BAR, 0, XCD_BAR_WORDS * sizeof(unsigned), stream);
    Params p{};
    for (int i = 0; i < 24; ++i) p.in[i] = (const float*)d_in[i];
    p.out = (float*)d_out; p.ws = (unsigned char*)d_ws;
    for (int i = 0; i < 16; ++i) p.inv_freq[i] = (float)pow(10000.0, -(double)i / 16.0);
#if MK_MULTI
    for (int s = 0; s < 40; ++s) {
        p.step_lo = s; p.step_hi = s + 1;
        hipLaunchKernelGGL(mega_fwd, dim3(grid), dim3(NTHREADS), LDS_BYTES, stream, p);
    }
#else
    p.step_lo = 0; p.step_hi = 1000;
    void* args[] = {&p};
    hipError_t e = hipLaunchCooperativeKernel((const void*)mega_fwd, dim3(grid), dim3(NTHREADS), args, LDS_BYTES, stream);
    if (e != hipSuccess) fprintf(stderr, "cooperative launch failed: %s (grid %d)\n", hipGetErrorString(e), grid);
#endif
}
```

```cpp
#include <hip/hip_runtime.h>
#include <hip/hip_cooperative_groups.h>
#include <cstdio>
#include <cstdint>
#include <cmath>
namespace cg = cooperative_groups;
namespace pg8 {
#define PG8_LAS __attribute__((address_space(3)))
typedef unsigned short bf16_t;
typedef short bf16x8 __attribute__((ext_vector_type(8)));
typedef float f32x4 __attribute__((ext_vector_type(4)));
typedef unsigned u32x4 __attribute__((ext_vector_type(4)));
constexpr int BM = 256, BK = 64, HALF = 128, HTB = HALF * BK * 2  , STAGE_BYTES = 8 * HTB, NXCD = 8, WGM = 8;

__host__ __device__ __forceinline__ int lds_byte(int r, int c) { const int st = (r >> 4) * 2 + (c >> 5), rr = r & 15, cc = c & 31, ob = rr * 64 + cc * 2; return st * 1024 + (ob ^ (((ob >> 9) & 1) << 5)); }
__host__ __device__ __forceinline__ void stage_rc(int b, int& R, int& C) { const int st = b / 1024, sb = b % 1024, swz = sb ^ (((sb >> 9) & 1) << 5); R = (st >> 1) * 16 + swz / 64; C = (st & 1) * 32 + (swz % 64) / 2; }
__host__ __device__ __forceinline__ int perm32(int rho) { const int n = rho >> 4, i = rho & 15; return 8 * (i >> 2) + 4 * n + (i & 3); }

struct Unit { int pm, pn; };
struct Gemm { const bf16_t* A; const bf16_t* Bt; int M, N, K, lda, ldb; };

struct StaticOrder {
    int nM, nN, nwg, G, c;
    __host__ __device__ void init(int M, int N, int G_, int c_) { nM = M / BM; nN = N / BM; nwg = nM * nN; G = G_; c = c_; }
    __host__ __device__ bool next(int i, Unit& u) const {
        const long L = (long)i * G + c; if (L >= nwg) return false;
        int wgid = (int)L; { const int q = nwg / NXCD, r = nwg % NXCD, xcd = wgid % NXCD, off = wgid / NXCD; wgid = (xcd < r ? xcd * (q + 1) : r * (q + 1) + (xcd - r) * q) + off; }
        const int nig = WGM * nN, gid = wgid / nig, fm = gid * WGM, gsz = (nM - fm) < WGM ? (nM - fm) : WGM;
        u.pm = fm + ((wgid % nig) % gsz); u.pn = (wgid % nig) / gsz; return true;
    }
    __device__ __forceinline__ void a_ready(const Unit&) const {}
    __device__ __forceinline__ void done(const Unit&) const {}
};

__device__ __forceinline__ unsigned cvt_pk_bf16(float lo, float hi) { unsigned r; asm volatile("v_cvt_pk_bf16_f32 %0, %1, %2" : "=v"(r) : "v"(lo), "v"(hi)); return r; }
typedef float f32x2 __attribute__((ext_vector_type(2)));
__device__ __forceinline__ f32x2 gelu_pk(f32x2 v) {
    const f32x2 av = __builtin_elementwise_abs(v), d = av * 0.2316418882f + 1.0f;
    f32x2 t; t.x = __builtin_amdgcn_rcpf(d.x); t.y = __builtin_amdgcn_rcpf(d.y);
    f32x2 q = t * 0.5307027145f + (-0.7265760135f); q = q * t + 0.7107068705f; q = q * t + (-0.142248368f); q = q * t + 0.127414796f; q = q * t;
    const f32x2 s = (v * v) * (-0.72134752044f);
    f32x2 e; e.x = __builtin_amdgcn_exp2f(s.x); e.y = __builtin_amdgcn_exp2f(s.y);
    const f32x2 m = v * (q * e), r = v - m;
    f32x2 o; o.x = v.x < 0.f ? m.x : r.x; o.y = v.y < 0.f ? m.y : r.y; return o;
}
template <class Epi, class Sched, bool ALIGN_EPI = false, bool SP2 = false>
__device__ __forceinline__ void gemm_phase(PG8_LAS unsigned char* lds, const Gemm g, const Sched& S, const Epi& E) {
    int tid_l = threadIdx.x; asm volatile("" : "+v"(tid_l)); const int tid = tid_l, wid = __builtin_amdgcn_readfirstlane(tid >> 6), lane = tid & 63, wr = wid >> 2, wc = wid & 3, fr = lane & 15, fq = lane >> 4;
    const int K = g.K, nt = K / BK;
    unsigned voffA[2], voffB[2];
#pragma unroll
    for (int i = 0; i < 2; ++i) { int R, C; stage_rc(tid * 16 + i * 8192, R, C); const int Rb = Epi::PERM ? ((R & ~31) + perm32(R & 31)) : R;
        voffA[i] = (unsigned)(R * g.lda + C) * 2u; voffB[i] = (unsigned)(Rb * g.ldb + C) * 2u; }
    const size_t kstep = (size_t)(BK * 2);
    const size_t hstepA = (size_t)HALF * g.lda * 2, hstepB = (size_t)HALF * g.ldb * 2;
    const size_t tstepA = 2 * hstepA, tstepB = 2 * hstepB;
    const unsigned ldsw = (unsigned)wid * 1024u;
    const int aoff = lds_byte(wr * 64 + fr, fq * 8), boff = lds_byte(wc * 32 + fr, fq * 8);
#define PG8_SA(b, h) (((b) * 2 + (h)) * HTB)
#define PG8_SB(b, h) ((4 + (b) * 2 + (h)) * HTB)
#define PG8_STAGE(bufoff, gbase, voff) do { _Pragma("unroll") for (int _i = 0; _i < 2; ++_i) \
        __builtin_amdgcn_global_load_lds((const unsigned*)((const char*)(gbase) + (voff)[_i]), (PG8_LAS unsigned*)(lds + (bufoff) + ldsw + _i * 8192), 16, 0, 0); } while (0)
#define PG8_LDA(dst, b, h) do { _Pragma("unroll") for (int m = 0; m < 4; ++m) _Pragma("unroll") for (int k = 0; k < 2; ++k) dst[m][k] = *(const PG8_LAS bf16x8*)(lds + PG8_SA(b, h) + aoff + m * 2048 + k * 1024); } while (0)
#define PG8_LDB(dst, b, h) do { _Pragma("unroll") for (int n = 0; n < 2; ++n) _Pragma("unroll") for (int k = 0; k < 2; ++k) dst[n][k] = *(const PG8_LAS bf16x8*)(lds + PG8_SB(b, h) + boff + n * 2048 + k * 1024); } while (0)
#define PG8_MMA(ai, bj, At, Bt) do { __builtin_amdgcn_s_setprio(1); _Pragma("unroll") for (int m = 0; m < 4; ++m) _Pragma("unroll") for (int n = 0; n < 2; ++n) _Pragma("unroll") for (int k = 0; k < 2; ++k) \
        acc[ai][bj][m][n] = __builtin_amdgcn_mfma_f32_16x16x32_bf16(Bt[n][k], At[m][k], acc[ai][bj][m][n], 0, 0, 0); __builtin_amdgcn_s_setprio(0); } while (0)
#define PG8_WAIT_V(n) asm volatile("s_waitcnt vmcnt(" #n ")" ::: "memory")
#define PG8_WAIT_L(n) asm volatile("s_waitcnt lgkmcnt(" #n ")" ::: "memory")
#define PG8_BAR __builtin_amdgcn_s_barrier()
#define PG8_SCHED __builtin_amdgcn_sched_barrier(0)
    Unit cur, nxt; int ui = 0;
    if (!S.next(0, cur)) return;
    f32x4 acc[2][2][4][2];
#pragma unroll
    for (int a = 0; a < 2; ++a)
#pragma unroll
        for (int b = 0; b < 2; ++b)
#pragma unroll
            for (int m = 0; m < 4; ++m)
#pragma unroll
                for (int n = 0; n < 2; ++n) acc[a][b][m][n] = (f32x4){0.f, 0.f, 0.f, 0.f};
    bf16x8 At[4][2], B0[2][2], B1[2][2];
    const char* cA = (const char*)g.A + (size_t)cur.pm * tstepA; const char* cB = (const char*)g.Bt + (size_t)cur.pn * tstepB;
    S.a_ready(cur);
    if constexpr (SP2) {
        PG8_STAGE(PG8_SB(0, 0), cB, voffB); PG8_STAGE(PG8_SB(0, 1), cB + hstepB, voffB); PG8_STAGE(PG8_SA(0, 0), cA, voffA); PG8_STAGE(PG8_SA(0, 1), cA + hstepA, voffA);
        if (wr == 1) PG8_BAR;
        PG8_WAIT_V(2); PG8_BAR;
        PG8_STAGE(PG8_SB(1, 0), cB + kstep, voffB); PG8_STAGE(PG8_SA(1, 0), cA + kstep, voffA); PG8_STAGE(PG8_SB(1, 1), cB + hstepB + kstep, voffB);
        PG8_WAIT_V(6); PG8_BAR;
    } else {
        PG8_STAGE(PG8_SB(0, 0), cB, voffB); PG8_STAGE(PG8_SA(0, 0), cA, voffA); PG8_STAGE(PG8_SB(0, 1), cB + hstepB, voffB); PG8_STAGE(PG8_SA(0, 1), cA + hstepA, voffA);
        if (wr == 1) PG8_BAR;
        PG8_WAIT_V(4); PG8_BAR;
        PG8_STAGE(PG8_SB(1, 0), cB + kstep, voffB); PG8_STAGE(PG8_SA(1, 0), cA + kstep, voffA); PG8_STAGE(PG8_SB(1, 1), cB + hstepB + kstep, voffB);
        PG8_WAIT_V(6); PG8_BAR;
    }
    for (;;) {
        const bool has_next = S.next(ui + 1, nxt);
        const char* nA = has_next ? (const char*)g.A + (size_t)nxt.pm * tstepA : cA; const char* nB = has_next ? (const char*)g.Bt + (size_t)nxt.pn * tstepB : cB;
        for (int t = 0; t < nt; t += 2) {
            const bool last = (t == nt - 2);
            const char* a1 = cA + (size_t)(t + 1) * kstep;
            const char* a2 = last ? nA : cA + (size_t)(t + 2) * kstep; const char* b2 = last ? nB : cB + (size_t)(t + 2) * kstep;
            const char* a3 = a2 + kstep; const char* b3 = b2 + kstep;
            if (last && has_next) S.a_ready(nxt);
            if constexpr (SP2) {
            PG8_LDB(B0, 0, 0); PG8_LDB(B1, 0, 1); PG8_SCHED; PG8_LDA(At, 0, 0); PG8_STAGE(PG8_SA(1, 1), a1 + hstepA, voffA);
            PG8_WAIT_V(8); PG8_WAIT_L(0); PG8_BAR; PG8_MMA(0, 0, At, B0); PG8_MMA(0, 1, At, B1); PG8_BAR; PG8_SCHED;
            PG8_LDA(At, 0, 1); PG8_STAGE(PG8_SB(0, 0), b2, voffB); PG8_STAGE(PG8_SB(0, 1), b2 + hstepB, voffB); PG8_STAGE(PG8_SA(0, 0), a2, voffA);
            PG8_WAIT_V(8); PG8_WAIT_L(0); PG8_BAR; PG8_MMA(1, 0, At, B0); PG8_MMA(1, 1, At, B1); PG8_BAR; PG8_SCHED;
            PG8_LDB(B0, 1, 0); PG8_LDB(B1, 1, 1); PG8_SCHED; PG8_LDA(At, 1, 0); PG8_STAGE(PG8_SA(0, 1), a2 + hstepA, voffA);
            PG8_WAIT_V(8); PG8_WAIT_L(0); PG8_BAR; PG8_MMA(0, 0, At, B0); PG8_MMA(0, 1, At, B1); PG8_BAR; PG8_SCHED;
            PG8_LDA(At, 1, 1); PG8_STAGE(PG8_SB(1, 0), b3, voffB); PG8_STAGE(PG8_SB(1, 1), b3 + hstepB, voffB); PG8_STAGE(PG8_SA(1, 0), a3, voffA);
            PG8_WAIT_V(8); PG8_WAIT_L(0); PG8_BAR; PG8_MMA(1, 0, At, B0); PG8_MMA(1, 1, At, B1); PG8_BAR; PG8_SCHED;
            } else {
            PG8_LDB(B0, 0, 0); PG8_SCHED; PG8_LDA(At, 0, 0); PG8_STAGE(PG8_SA(1, 1), a1 + hstepA, voffA);
            PG8_WAIT_L(8); PG8_BAR; PG8_WAIT_L(0); PG8_MMA(0, 0, At, B0); PG8_BAR; PG8_SCHED;
            PG8_LDB(B1, 0, 1); PG8_STAGE(PG8_SB(0, 0), b2, voffB);
            PG8_BAR; PG8_WAIT_L(0); PG8_MMA(0, 1, At, B1); PG8_BAR;
            PG8_LDA(At, 0, 1); PG8_STAGE(PG8_SA(0, 0), a2, voffA);
            PG8_BAR; PG8_WAIT_L(0); PG8_MMA(1, 0, At, B0); PG8_BAR; PG8_SCHED;
            PG8_STAGE(PG8_SB(0, 1), b2 + hstepB, voffB);
            PG8_WAIT_V(6); PG8_BAR; PG8_MMA(1, 1, At, B1); PG8_BAR;
            PG8_LDB(B0, 1, 0); PG8_SCHED; PG8_LDA(At, 1, 0); PG8_STAGE(PG8_SA(0, 1), a2 + hstepA, voffA);
            PG8_WAIT_L(8); PG8_BAR; PG8_WAIT_L(0); PG8_MMA(0, 0, At, B0); PG8_BAR; PG8_SCHED;
            PG8_LDB(B1, 1, 1); PG8_STAGE(PG8_SB(1, 0), b3, voffB);
            PG8_BAR; PG8_WAIT_L(0); PG8_MMA(0, 1, At, B1); PG8_BAR;
            PG8_LDA(At, 1, 1); PG8_STAGE(PG8_SA(1, 0), a3, voffA);
            PG8_BAR; PG8_WAIT_L(0); PG8_MMA(1, 0, At, B0); PG8_BAR; PG8_SCHED;
            PG8_STAGE(PG8_SB(1, 1), b3 + hstepB, voffB);
            PG8_WAIT_V(6); PG8_BAR; PG8_MMA(1, 1, At, B1); PG8_BAR;
            }
        }
        if constexpr (ALIGN_EPI) { if (wr == 0) PG8_BAR; }
        if constexpr (!Epi::AFTER_DRAIN) { E(acc, cur, wr, wc, fr, fq); S.done(cur); }
        if (!has_next) break;
#pragma unroll
        for (int a = 0; a < 2; ++a)
#pragma unroll
            for (int b = 0; b < 2; ++b)
#pragma unroll
                for (int m = 0; m < 4; ++m)
#pragma unroll
                    for (int n = 0; n < 2; ++n) acc[a][b][m][n] = (f32x4){0.f, 0.f, 0.f, 0.f};
        cur = nxt; cA = nA; cB = nB; ++ui;
        if constexpr (ALIGN_EPI) { if (wr == 1) PG8_BAR; }
    }
    PG8_WAIT_V(0);
    if constexpr (!ALIGN_EPI) { if (wr == 0) PG8_BAR; }
    PG8_BAR;
    if constexpr (Epi::AFTER_DRAIN) { E.fused(acc, cur, wr, wc, fr, fq, lds, wid, lane); S.done(cur); }
#undef PG8_SA
#undef PG8_SB
#undef PG8_STAGE
#undef PG8_LDA
#undef PG8_LDB
#undef PG8_MMA
#undef PG8_WAIT_V
#undef PG8_WAIT_L
#undef PG8_BAR
#undef PG8_SCHED
}
}
#define LAS __attribute__((address_space(3)))
#define XB_TMO      128
#define XB_XCNT(j)  (256  + 64 * (j))
#define XB_XSUB(j)  (1280 + 64 * (j))
#define XB_XGEN(j)  (2304 + 64 * (j))
#define XB_TOP      3328
#define XB_TOPGEN   3392
#define XCD_BAR_WORDS 3456
#define XB_SPIN_CAP (1u << 18)

__device__ __forceinline__ unsigned xb_ld(unsigned* p)              { return __hip_atomic_load(p, __ATOMIC_RELAXED, __HIP_MEMORY_SCOPE_AGENT); }
__device__ __forceinline__ unsigned xb_add(unsigned* p, unsigned v) { return __hip_atomic_fetch_add(p, v, __ATOMIC_RELAXED, __HIP_MEMORY_SCOPE_AGENT); }
__device__ __forceinline__ unsigned xb_xcc_id() { return (unsigned)__builtin_amdgcn_s_getreg((3 << 11) | 20) & 0xFu; }
#define XB_SPIN(cond, bar) do { unsigned _sp = 0; while (cond) { __builtin_amdgcn_s_sleep(1); \
    if ((++_sp & 255u) == 0u) { if (xb_ld(&(bar)[XB_TMO])) break; if (_sp > XB_SPIN_CAP) { atomicAdd(&(bar)[XB_TMO], 1u); break; } } } } while (0)

struct XcdBarrier {
    unsigned* bar; unsigned x;
    volatile LAS unsigned* st;
};

__device__ __forceinline__ XcdBarrier xcd_barrier_post(unsigned* bar, volatile LAS unsigned* st) {
    XcdBarrier b; b.bar = bar; b.x = xb_xcc_id(); b.st = st;
    if (threadIdx.x == 0) (void)xb_add(&bar[XB_XCNT(b.x)], 1u);
    return b;
}
__device__ __forceinline__ void xcd_barrier_complete(unsigned* bar, unsigned x, unsigned& nloc, unsigned& nx) {
    const unsigned G = gridDim.x * gridDim.y * gridDim.z;
    unsigned sum, cnt, mine, sp = 0u;
    for (;;) {
        sum = 0u; cnt = 0u; mine = 0u;
#pragma unroll
        for (unsigned j = 0; j < 16; ++j) { const unsigned c = xb_ld(&bar[XB_XCNT(j)]); sum += c; cnt += (c > 0u) ? 1u : 0u; mine = (j == x) ? c : mine; }
        if (sum == G) break;
        __builtin_amdgcn_s_sleep(1);
        if ((++sp & 255u) == 0u) { if (xb_ld(&bar[XB_TMO])) break; if (sp > XB_SPIN_CAP) { atomicAdd(&bar[XB_TMO], 1u); break; } }
    }
    nloc = mine > 0u ? mine : 1u; nx = cnt > 0u ? cnt : 1u;
}

__device__ __forceinline__ void xcd_barrier(const XcdBarrier& b) {
    asm volatile("s_waitcnt vmcnt(0)" ::: "memory");
    __syncthreads();
    if (threadIdx.x == 0) {
        unsigned* bar = b.bar;
        __builtin_amdgcn_s_waitcnt(0);
        unsigned nloc = b.st[0], nx = b.st[1];
        if (nloc == 0u) { xcd_barrier_complete(bar, b.x, nloc, nx); b.st[0] = nloc; b.st[1] = nx; }
        const unsigned old = xb_add(&bar[XB_XSUB(b.x)], 1u);
        const unsigned gen = old / nloc;
        if (old + 1u == (gen + 1u) * nloc) {
            __builtin_amdgcn_fence(__ATOMIC_RELEASE, "agent");
            asm volatile("s_waitcnt vmcnt(0)" ::: "memory");
            const unsigned og = xb_add(&bar[XB_TOP], 1u);
            const unsigned tg = og / nx;
            if (og + 1u == (tg + 1u) * nx) xb_add(&bar[XB_TOPGEN], 1u);
            else XB_SPIN(xb_ld(&bar[XB_TOPGEN]) == tg, bar);
            __builtin_amdgcn_fence(__ATOMIC_ACQUIRE, "agent");
            xb_add(&bar[XB_XGEN(b.x)], 1u);
            asm volatile("s_waitcnt vmcnt(0)" ::: "memory");
        } else {
            XB_SPIN(xb_ld(&bar[XB_XGEN(b.x)]) == gen, bar);
            __builtin_amdgcn_fence(__ATOMIC_ACQUIRE, "agent");
            asm volatile("s_waitcnt vmcnt(0)" ::: "memory");
        }
    }
    __syncthreads();
}

typedef unsigned short bf16_t;
typedef short bf16x8 __attribute__((ext_vector_type(8)));
typedef short s16x4 __attribute__((ext_vector_type(4)));
typedef float f32x4 __attribute__((ext_vector_type(4)));
typedef float f32x2 __attribute__((ext_vector_type(2)));
typedef float f32x16 __attribute__((ext_vector_type(16)));
typedef unsigned u32x4 __attribute__((ext_vector_type(4)));
typedef unsigned u32x2 __attribute__((ext_vector_type(2)));

constexpr int S = 16384, DM = 1024, FF = 2816, NGU = 2 * FF;
constexpr int PW = 1792;
constexpr int P_CQ = 0, P_CKV = 384, P_KR = 640, P_U = 768, P_V = 1280;
constexpr int QW = 768;
constexpr float EPS = 1e-6f;
constexpr int NTHREADS = 512, NWAVES = 8;
constexpr int LDS_BYTES = 147456;
constexpr int LDS_MISC = 131072;

constexpr size_t MiB = (size_t)1 << 20;
constexpr size_t OFF_SS = 342 * MiB;
constexpr size_t OFF_ROPE = 2 * MiB;
constexpr size_t OFF_WGU = 4 * MiB;
constexpr size_t OFF_WD = 92 * MiB;
constexpr size_t OFF_WIN = 136 * MiB;
constexpr size_t OFF_WUQ = 143 * MiB;
constexpr size_t OFF_WUKV = 145 * MiB;
constexpr size_t OFF_WOUT = 146 * MiB;
constexpr size_t OFF_WCIN = 150 * MiB;
constexpr size_t OFF_WCOUT = 162 * MiB;
constexpr size_t OFF_XB = 166 * MiB;
constexpr size_t OFF_ACT = 198 * MiB;
constexpr size_t OFF_P = OFF_ACT, OFF_Q = OFF_ACT + 56 * MiB, OFF_KN = OFF_ACT + 80 * MiB, OFF_V = OFF_ACT + 96 * MiB, OFF_MIX = OFF_ACT + 112 * MiB;
constexpr size_t OFF_CZ = OFF_ACT, OFF_BG = OFF_ACT + 32 * MiB, OFF_G = OFF_ACT + 64 * MiB;
constexpr size_t OFF_BAR = 361 * MiB;
constexpr size_t OFF_WSG = 362 * MiB;
constexpr size_t WS_END = 363 * MiB;

struct Params {
    const float* in[24];
    float* out;
    unsigned char* ws;
    float inv_freq[16];
    int step_lo, step_hi;
};

__device__ __forceinline__ float bf2f(unsigned short b) { return __uint_as_float((unsigned)b << 16); }
__device__ __forceinline__ unsigned pk_bf16(float lo, float hi) { return pg8::cvt_pk_bf16(lo, hi); }
__device__ __forceinline__ int crow(int r, int h) { return (r & 3) + 8 * (r >> 2) + 4 * h; }
__device__ __forceinline__ float swap32_max(float v) {
    auto rr = __builtin_amdgcn_permlane32_swap(__float_as_uint(v), __float_as_uint(v), false, false);
    return fmaxf(__uint_as_float(rr[0]), __uint_as_float(rr[1]));
}
__device__ __forceinline__ float swap32_sum(float v) {
    auto rr = __builtin_amdgcn_permlane32_swap(__float_as_uint(v), __float_as_uint(v), false, false);
    return __uint_as_float(rr[0]) + __uint_as_float(rr[1]);
}

__device__ __forceinline__ float row_ss(const float* st, int row, int nsl) {
    const f32x4* q = (const f32x4*)(st + (size_t)row * 16);
    const f32x4 a = q[0], b = q[1];
    float s = ((a[0] + a[1]) + (a[2] + a[3])) + ((b[0] + b[1]) + (b[2] + b[3]));
    if (nsl > 8) { const f32x4 c = q[2]; s += (c[0] + c[1]) + (c[2] + c[3]); }
    if (nsl > 12) { const f32x4 d = q[3]; s += (d[0] + d[1]) + (d[2] + d[3]); }
    return s;
}
__device__ __forceinline__ f32x4 row_ss_part(const float* st, int row, int nsl, int fq) {
    return (4 * fq < nsl) ? ((const f32x4*)(st + (size_t)row * 16))[fq] : (f32x4){0.f, 0.f, 0.f, 0.f};
}
__device__ __forceinline__ float row_ss_fin(const f32x4 v) {
    float s = (v[0] + v[1]) + (v[2] + v[3]);
    s += __shfl_xor(s, 16); s += __shfl_xor(s, 32);
    return s;
}

struct EpiPair {
    static constexpr bool PERM = true, AFTER_DRAIN = false;
    bf16_t* O; int ldo; const float* ss; float inv_dim; int mode;
    __device__ __forceinline__ void operator()(const f32x4 (&acc)[2][2][4][2], const pg8::Unit& u, int wr, int wc, int fr, int fq) const {
        const int row0 = u.pm * 256 + wr * 64 + fr, col0 = u.pn * 128 + wc * 32 + 8 * fq;
        f32x4 sp[2][4]; float rsv[2][4];
#pragma unroll
        for (int ai = 0; ai < 2; ++ai)
#pragma unroll
            for (int m = 0; m < 4; ++m) sp[ai][m] = row_ss_part(ss, row0 + ai * 128 + m * 16, 16, fq);
#pragma unroll
        for (int ai = 0; ai < 2; ++ai)
#pragma unroll
            for (int m = 0; m < 4; ++m) rsv[ai][m] = rsqrtf(row_ss_fin(sp[ai][m]) * inv_dim + EPS);
        if (mode == 0) {
#pragma unroll
            for (int ai = 0; ai < 2; ++ai)
#pragma unroll
                for (int m = 0; m < 4; ++m) {
                    const int row = row0 + ai * 128 + m * 16;
                    const float rs = rsv[ai][m], c1 = rs * -1.4426950408889634f, rs2 = rs * rs;
                    f32x2 h[4];
#pragma unroll
                    for (int n = 0; n < 2; ++n)
#pragma unroll
                        for (int q = 0; q < 2; ++q) {
                            const f32x2 A = {acc[ai][0][m][n][2 * q], acc[ai][0][m][n][2 * q + 1]}, B = {acc[ai][1][m][n][2 * q], acc[ai][1][m][n][2 * q + 1]};
                            const f32x2 ab = A * B, ea = A * c1;
                            f32x2 d; d.x = __builtin_amdgcn_exp2f(ea.x); d.y = __builtin_amdgcn_exp2f(ea.y);
                            d = d + 1.0f;
                            f32x2 r; r.x = __builtin_amdgcn_rcpf(d.x); r.y = __builtin_amdgcn_rcpf(d.y);
                            h[n * 2 + q] = ab * (r * rs2);
                        }
                    u32x4 w; w.x = pk_bf16(h[0].x, h[0].y); w.y = pk_bf16(h[1].x, h[1].y); w.z = pk_bf16(h[2].x, h[2].y); w.w = pk_bf16(h[3].x, h[3].y);
                    *(u32x4*)(O + (size_t)row * ldo + col0) = w;
                }
        } else {
#pragma unroll
            for (int ai = 0; ai < 2; ++ai)
#pragma unroll
                for (int m = 0; m < 4; ++m) {
                    const int row = row0 + ai * 128 + m * 16;
                    const float rs2 = rsv[ai][m] * rsv[ai][m];
                    f32x2 h[4];
#pragma unroll
                    for (int n = 0; n < 2; ++n)
#pragma unroll
                        for (int q = 0; q < 2; ++q) {
                            const f32x2 A = {acc[ai][0][m][n][2 * q], acc[ai][0][m][n][2 * q + 1]}, B = {acc[ai][1][m][n][2 * q], acc[ai][1][m][n][2 * q + 1]};
                            h[n * 2 + q] = (A * B) * rs2;
                        }
                    u32x4 w; w.x = pk_bf16(h[0].x, h[0].y); w.y = pk_bf16(h[1].x, h[1].y); w.z = pk_bf16(h[2].x, h[2].y); w.w = pk_bf16(h[3].x, h[3].y);
                    *(u32x4*)(O + (size_t)row * ldo + col0) = w;
                }
        }
    }
};

struct EpiRes {
    static constexpr bool PERM = true, AFTER_DRAIN = false;
    bf16_t* XB; float* ss_out; float alpha;
    __device__ __forceinline__ void operator()(const f32x4 (&acc)[2][2][4][2], const pg8::Unit& u, int wr, int wc, int fr, int fq) const {
        const int row0 = u.pm * 256 + wr * 64 + fr, col0 = u.pn * 256 + wc * 32 + 8 * fq;
#pragma unroll
        for (int ai = 0; ai < 2; ++ai)
#pragma unroll
            for (int m = 0; m < 4; ++m) {
                const int row = row0 + ai * 128 + m * 16;
                float sq = 0.f;
#pragma unroll
                for (int bj = 0; bj < 2; ++bj) {
                    bf16_t* px = XB + (size_t)row * DM + col0 + bj * 128;
                    const u32x4 xo = *(const u32x4*)px;
                    u32x4 w;
#pragma unroll
                    for (int i = 0; i < 4; ++i) {
                        const float lo = __uint_as_float(xo[i] << 16) + acc[ai][bj][m][i >> 1][(i & 1) * 2] * alpha;
                        const float hi = __uint_as_float(xo[i] & 0xffff0000u) + acc[ai][bj][m][i >> 1][(i & 1) * 2 + 1] * alpha;
                        const unsigned pk = pk_bf16(lo, hi);
                        w[i] = pk;
                        const float rl = __uint_as_float(pk << 16), rh = __uint_as_float(pk & 0xffff0000u);
                        sq += rl * rl + rh * rh;
                    }
                    *(u32x4*)px = w;
                }
                sq += __shfl_xor(sq, 16); sq += __shfl_xor(sq, 32);
                if (fq == 0) ss_out[(size_t)row * 16 + u.pn * 4 + wc] = sq;
                asm volatile("" ::: "memory");
            }
    }
};

struct EpiRow {
    static constexpr bool PERM = true, AFTER_DRAIN = false;
    bf16_t* O; int ldo; int split_tiles; size_t split_stride;
    const float* ss; float inv_dim; int nsl;
    int gelu_from; int rope_pn, rope_bj, rope_wc;
    const float* cs; const float* sn;
    unsigned long long stat_map; float* stb;
    __device__ __forceinline__ void operator()(const f32x4 (&acc)[2][2][4][2], const pg8::Unit& u, int wr, int wc, int fr, int fq) const {
        const int row0 = u.pm * 256 + wr * 64 + fr;
        int colt = u.pn * 256; bf16_t* base = O;
        if (split_tiles && u.pn >= split_tiles) { base += split_stride; colt -= split_tiles * 256; }
        const bool do_gelu = u.pn >= gelu_from;
        f32x4 sp[2][4]; float rsv[2][4];
#pragma unroll
        for (int ai = 0; ai < 2; ++ai)
#pragma unroll
            for (int m = 0; m < 4; ++m) sp[ai][m] = row_ss_part(ss, row0 + ai * 128 + m * 16, nsl, fq);
#pragma unroll
        for (int ai = 0; ai < 2; ++ai)
#pragma unroll
            for (int m = 0; m < 4; ++m) rsv[ai][m] = rsqrtf(row_ss_fin(sp[ai][m]) * inv_dim + EPS);
#pragma unroll
        for (int bj = 0; bj < 2; ++bj) {
            const bool do_rope = (u.pn == rope_pn) && (rope_bj < 0 || (bj == rope_bj && wc == rope_wc));
            const int sidx = (int)((stat_map >> (4 * (u.pn * 2 + bj))) & 15ull);
            float* st = stb + (size_t)(sidx > 0 ? sidx - 1 : 0) * ((size_t)S * 16);
            const int sbase = (int)((0x0a0300u >> (8 * (sidx > 0 ? sidx - 1 : 0))) & 255u);
            const int col0 = colt + bj * 128 + wc * 32 + 8 * fq;
#pragma unroll
            for (int ai = 0; ai < 2; ++ai)
#pragma unroll
                for (int m = 0; m < 4; ++m) {
                    const int row = row0 + ai * 128 + m * 16;
                    const float rs = rsv[ai][m];
                    float v[8];
#pragma unroll
                    for (int n = 0; n < 2; ++n)
#pragma unroll
                        for (int j = 0; j < 4; ++j) v[n * 4 + j] = acc[ai][bj][m][n][j] * rs;
                    if (do_gelu) {
#pragma unroll
                        for (int i = 0; i < 8; i += 2) { const f32x2 g = pg8::gelu_pk((f32x2){v[i], v[i + 1]}); v[i] = g.x; v[i + 1] = g.y; }
                    }
                    if (do_rope) {
                        const f32x4 c0 = *(const f32x4*)(cs + (size_t)row * 16 + 8 * (fq & 1)), c1 = *(const f32x4*)(cs + (size_t)row * 16 + 8 * (fq & 1) + 4);
                        const f32x4 s0 = *(const f32x4*)(sn + (size_t)row * 16 + 8 * (fq & 1)), s1 = *(const f32x4*)(sn + (size_t)row * 16 + 8 * (fq & 1) + 4);
                        const float sg = (fq < 2) ? -1.f : 1.f;
#pragma unroll
                        for (int i = 0; i < 8; ++i) {
                            const float pt = __shfl_xor(v[i], 32);
                            const float cc = i < 4 ? c0[i & 3] : c1[i & 3], sv = i < 4 ? s0[i & 3] : s1[i & 3];
                            v[i] = v[i] * cc + sg * pt * sv;
                        }
                    }
                    if (sidx) {
                        float sq = 0.f;
#pragma unroll
                        for (int i = 0; i < 8; ++i) sq += v[i] * v[i];
                        sq += __shfl_xor(sq, 16); sq += __shfl_xor(sq, 32);
                        if (fq == 0) st[(size_t)row * 16 + (u.pn * 2 + bj - sbase) * 4 + wc] = sq;
                    }
                    u32x4 w; w.x = pk_bf16(v[0], v[1]); w.y = pk_bf16(v[2], v[3]); w.z = pk_bf16(v[4], v[5]); w.w = pk_bf16(v[6], v[7]);
                    *(u32x4*)(base + (size_t)row * ldo + col0) = w;
                }
        }
    }
};

struct Job { const float* W; int K, N; bf16_t* dst; const float* gain; int mode; float scale; };
enum { M_PLAIN = 0, M_GATE, M_UP, M_EVENIN, M_Q, M_KV, M_CONVIN };
constexpr float Q_SCALE = 0.10206207261596577f * 1.4426950408889634f;

__device__ __forceinline__ int job_items(int j) {
    if (j < 24) { const int t = j % 6; return (t == 2 || t == 5) ? 44 * 32 : 16 * 88; }
    if (j < 32) { const int t = (j - 24) & 3; return t == 0 ? 16 * 53 : (t == 1 ? 6 * 24 : (t == 2 ? 4 * 32 : 16 * 32)); }
    return ((j - 32) & 1) ? 16 * 32 : 16 * 96;
}
__device__ __forceinline__ Job get_job(const Params& p, int j) {
    Job b; b.scale = 1.f; b.gain = nullptr; b.mode = M_PLAIN;
    unsigned char* ws = p.ws;
    if (j < 24) {
        const int l = j / 6, t = j % 6, post = t >= 3, tt = t % 3;
        const float* nrm = p.in[post ? 7 : 2] + l * DM;
        const float* wg = p.in[post ? 8 : 3] + (size_t)l * DM * FF;
        const float* wu = p.in[post ? 9 : 4] + (size_t)l * DM * FF;
        const float* wd = p.in[post ? 10 : 5] + (size_t)l * DM * FF;
        if (tt == 0) { b.W = wg; b.K = DM; b.N = FF; b.dst = (bf16_t*)(ws + OFF_WGU) + (size_t)(2 * l + post) * NGU * DM; b.gain = nrm; b.mode = M_GATE; }
        else if (tt == 1) { b.W = wu; b.K = DM; b.N = FF; b.dst = (bf16_t*)(ws + OFF_WGU) + (size_t)(2 * l + post) * NGU * DM; b.gain = nrm; b.mode = M_UP; }
        else { b.W = wd; b.K = FF; b.N = DM; b.dst = (bf16_t*)(ws + OFF_WD) + (size_t)(2 * l + post) * DM * FF; }
    } else if (j < 32) {
        const int e = (j - 24) >> 2, t = (j - 24) & 3;
        if (t == 0) { b.W = p.in[11] + (size_t)e * DM * 1696; b.K = DM; b.N = 1696; b.dst = (bf16_t*)(ws + OFF_WIN) + (size_t)e * PW * DM; b.gain = p.in[6] + (2 * e) * DM; b.mode = M_EVENIN; }
        else if (t == 1) { b.W = p.in[13] + (size_t)e * 384 * 768; b.K = 384; b.N = 768; b.dst = (bf16_t*)(ws + OFF_WUQ) + (size_t)e * 768 * 384; b.gain = p.in[12] + e * 384; b.mode = M_Q; b.scale = Q_SCALE; }
        else if (t == 2) { b.W = p.in[15] + (size_t)e * 256 * 1024; b.K = 256; b.N = 1024; b.dst = (bf16_t*)(ws + OFF_WUKV) + (size_t)e * 1024 * 256; b.gain = p.in[14] + e * 256; b.mode = M_KV; }
        else { b.W = p.in[19] + (size_t)e * DM * DM; b.K = DM; b.N = DM; b.dst = (bf16_t*)(ws + OFF_WOUT) + (size_t)e * DM * DM; }
    } else {
        const int o = (j - 32) >> 1, t = (j - 32) & 1;
        if (t == 0) { b.W = p.in[20] + (size_t)o * DM * 3072; b.K = DM; b.N = 3072; b.dst = (bf16_t*)(ws + OFF_WCIN) + (size_t)o * 3072 * DM; b.gain = p.in[6] + (2 * o + 1) * DM; b.mode = M_CONVIN; }
        else { b.W = p.in[22] + (size_t)o * DM * DM; b.K = DM; b.N = DM; b.dst = (bf16_t*)(ws + OFF_WCOUT) + (size_t)o * DM * DM; }
    }
    return b;
}
__device__ __forceinline__ int map_row(int mode, int n) {
    switch (mode) {
        case M_GATE: return 256 * (n >> 7) + (n & 127);
        case M_UP: return 256 * (n >> 7) + 128 + (n & 127);
        case M_EVENIN: return n < 672 ? n : n + 96;
        case M_Q: { const int hd = n / 96, d = n - hd * 96; return d < 64 ? hd * 64 + d : 512 + hd * 32 + (d - 64); }
        case M_KV: { const int hd = n >> 7, d = n & 127; return d < 64 ? hd * 64 + d : 512 + hd * 64 + (d - 64); }
        case M_CONVIN: { if (n < 1024) return 2048 + n; if (n < 2048) { const int jn = n - 1024; return 256 * (jn >> 7) + (jn & 127); } const int jn = n - 2048; return 256 * (jn >> 7) + 128 + (jn & 127); }
        default: return n;
    }
}
__device__ __forceinline__ void transpose_item(const Job& jb, LAS float* scr, int item, int lane) {
    const int nblk = jb.N / 32, kb = item / nblk, nb = item - kb * nblk, k0 = 64 * kb, n0 = 32 * nb;
    const int kr = lane >> 3, c4 = (lane & 7) * 4;
    f32x4 v[8]; float gk[8];
#pragma unroll
    for (int i = 0; i < 8; ++i) {
        const int kk = 8 * i + kr;
        v[i] = *(const f32x4*)(jb.W + (size_t)(k0 + kk) * jb.N + n0 + c4);
        gk[i] = (jb.gain ? jb.gain[k0 + kk] : 1.0f) * jb.scale;
    }
#pragma unroll
    for (int i = 0; i < 8; ++i) {
        const int kk = 8 * i + kr;
        LAS float* d = scr + kk * 33 + c4;
        d[0] = v[i][0] * gk[i]; d[1] = v[i][1] * gk[i]; d[2] = v[i][2] * gk[i]; d[3] = v[i][3] * gk[i];
    }
    asm volatile("s_waitcnt lgkmcnt(0)" ::: "memory");
    const int c = lane & 7, r0 = map_row(jb.mode, n0);
#pragma unroll
    for (int j = 0; j < 4; ++j) {
        const int n = (lane >> 3) + 8 * j; const LAS float* s = scr + (8 * c) * 33 + n;
        u32x4 o; o.x = pk_bf16(s[0 * 33], s[1 * 33]); o.y = pk_bf16(s[2 * 33], s[3 * 33]); o.z = pk_bf16(s[4 * 33], s[5 * 33]); o.w = pk_bf16(s[6 * 33], s[7 * 33]);
        *(u32x4*)(jb.dst + (size_t)(r0 + n) * jb.K + k0 + 8 * c) = o;
    }
    asm volatile("s_waitcnt lgkmcnt(0)" ::: "memory");
}

__device__ __forceinline__ void convert_jobs(const Params& p, LAS unsigned char* lds, int j_lo, int j_hi, int w, int nw, int lane, int wave) {
    LAS float* scr = (LAS float*)(lds + wave * 8704);
    int total = 0;
    for (int j = j_lo; j < j_hi; ++j) total += job_items(j);
    for (int it = w; it < total; it += nw) {
        int r = it, j = j_lo;
        for (; j < j_hi; ++j) { const int c = job_items(j); if (r < c) break; r -= c; }
        const Job jb = get_job(p, j);
        transpose_item(jb, scr, r, lane);
    }
}
__device__ __forceinline__ void prologue(const Params& p, LAS unsigned char* lds, int gw, int ngw, int lane, int wave) {
    unsigned char* ws = p.ws;
    {
        float* cs = (float*)(ws + OFF_ROPE); float* sn = cs + S * 16;
        const int* pos = (const int*)p.in[1];
        for (int idx = gw * 64 + lane; idx < S * 16; idx += ngw * 64) {
            const int t = idx >> 4, i = idx & 15;
            const float ang = (float)pos[t] * p.inv_freq[i];
            const double a = (double)ang;
            const double k = rint(a * 0.15915494309189535);
            const double r = a - k * 6.283185307179586;
            const double r2 = r * r;
            double ts = r, ssum = r, tc = 1.0, csum = 1.0;
#pragma unroll 1
            for (int q = 1; q <= 15; ++q) {
                tc *= -r2 / (double)((2 * q - 1) * (2 * q)); csum += tc;
                ts *= -r2 / (double)((2 * q) * (2 * q + 1)); ssum += ts;
            }
            cs[idx] = (float)csum; sn[idx] = (float)ssum;
        }
    }
    {
        const float* x = p.in[0]; bf16_t* XB = (bf16_t*)(ws + OFF_XB); float* ss0 = (float*)(ws + OFF_SS);
        for (int row = gw; row < S; row += ngw) {
            const f32x4* xr = (const f32x4*)(x + (size_t)row * DM) + lane;
            float s = 0.f;
#pragma unroll
            for (int j = 0; j < 4; ++j) {
                const f32x4 v = xr[64 * j];
                u32x2 w; w.x = pk_bf16(v[0], v[1]); w.y = pk_bf16(v[2], v[3]);
                ((u32x2*)(XB + (size_t)row * DM) + lane)[64 * j] = w;
                const float a = __uint_as_float(w.x << 16), b = __uint_as_float(w.x & 0xffff0000u), c = __uint_as_float(w.y << 16), d = __uint_as_float(w.y & 0xffff0000u);
                s += (a * a + b * b) + (c * c + d * d);
            }
#pragma unroll
            for (int o = 1; o < 64; o <<= 1) s += __shfl_xor(s, o);
            if (lane < 16) ss0[(size_t)row * 16 + lane] = (lane == 0) ? s : 0.f;
        }
    }
    {
        const float* sw = p.in[17]; unsigned* wo = (unsigned*)(ws + OFF_WSG);
        for (int i = gw * 64 + lane; i < 2 * 8 * 128 * 64; i += ngw * 64) {
            const int tt = (i >> 6) & 127, s2 = (i & 63) * 2;
            const f32x2 v = *(const f32x2*)(sw + (size_t)i * 2);
            wo[i] = pk_bf16(s2 <= tt ? v[0] : 0.f, s2 + 1 <= tt ? v[1] : 0.f);
        }
    }
    for (int e = 0; e < 2; ++e) {
        u32x4* z = (u32x4*)((bf16_t*)(ws + OFF_WIN) + (size_t)e * PW * DM + (size_t)672 * DM);
        for (int idx = gw * 64 + lane; idx < 96 * DM / 8; idx += ngw * 64) z[idx] = (u32x4){0u, 0u, 0u, 0u};
    }
    convert_jobs(p, lds, 0, 3, gw, ngw, lane, wave);
}

__device__ __forceinline__ void sgu_unit(LAS unsigned char* lds, int unit, const bf16_t* __restrict__ P, const float* __restrict__ ssv,
                                         const bf16_t* __restrict__ wsg, const float* __restrict__ sgb, const float* __restrict__ sgn, bf16_t* __restrict__ MIX) {
    int tid_l = threadIdx.x; asm volatile("" : "+v"(tid_l)); const int tid = tid_l, lane = tid & 63, wid = __builtin_amdgcn_readfirstlane(tid >> 6), r32 = lane & 31, hi = lane >> 5;
    const int chunk = unit >> 1, hf = unit & 1, s0 = chunk * 128;
    LAS float* rv = (LAS float*)lds;
    LAS unsigned short* vT = (LAS unsigned short*)(lds + 1024);
    u32x4 d[8];
#pragma unroll
    for (int i = 0; i < 8; ++i) { const int c = tid + 512 * i, srow = c & 127, part = c >> 7; d[i] = *(const u32x4*)(P + (size_t)(s0 + srow) * PW + P_V + hf * 256 + part * 8); }
    if (tid < 128) rv[tid] = rsqrtf(row_ss(ssv, s0 + tid, 16) * (1.0f / 512.0f) + EPS);
    const int gl = wid & 3, rh = wid >> 2, g = 4 * hf + gl;
    bf16x8 af[2][8];
#pragma unroll
    for (int mt = 0; mt < 2; ++mt)
#pragma unroll
        for (int ks = 0; ks < 8; ++ks) af[mt][ks] = *(const bf16x8*)(wsg + ((size_t)g * 128 + 64 * rh + 32 * mt + r32) * 128 + 16 * ks + 8 * hi);
    u32x2 uu[2][2][4];
#pragma unroll
    for (int mt = 0; mt < 2; ++mt)
#pragma unroll
        for (int nt = 0; nt < 2; ++nt)
#pragma unroll
            for (int rg = 0; rg < 4; ++rg) uu[mt][nt][rg] = *(const u32x2*)(P + (size_t)(s0 + 64 * rh + 32 * mt + r32) * PW + P_U + g * 64 + 32 * nt + 8 * rg + 4 * hi);
    f32x4 gnv[2][4]; float biasv[2];
#pragma unroll
    for (int nt = 0; nt < 2; ++nt)
#pragma unroll
        for (int rg = 0; rg < 4; ++rg) gnv[nt][rg] = *(const f32x4*)(sgn + g * 64 + 32 * nt + 8 * rg + 4 * hi);
#pragma unroll
    for (int mt = 0; mt < 2; ++mt) biasv[mt] = sgb[g * 128 + 64 * rh + 32 * mt + r32];
    __syncthreads();
#pragma unroll
    for (int i = 0; i < 8; ++i) {
        const int c = tid + 512 * i, srow = c & 127, part = c >> 7;
        const float r = rv[srow];
        LAS unsigned short* dst = vT + (size_t)(part * 8) * 136 + srow;
#pragma unroll
        for (int q = 0; q < 4; ++q) {
            const unsigned pk = pk_bf16(__uint_as_float(d[i][q] << 16) * r, __uint_as_float(d[i][q] & 0xffff0000u) * r);
            dst[(2 * q) * 136] = (unsigned short)(pk & 0xffffu); dst[(2 * q + 1) * 136] = (unsigned short)(pk >> 16);
        }
    }
    __syncthreads();
    f32x16 acc[2][2];
#pragma unroll
    for (int a = 0; a < 2; ++a)
#pragma unroll
        for (int b = 0; b < 2; ++b)
#pragma unroll
            for (int r = 0; r < 16; ++r) acc[a][b][r] = 0.f;
#pragma unroll
    for (int mt = 0; mt < 2; ++mt)
#pragma unroll
        for (int ks = 0; ks < 8; ++ks)
#pragma unroll
            for (int nt = 0; nt < 2; ++nt) {
                const bf16x8 bfr = *(const LAS bf16x8*)(vT + (size_t)(gl * 64 + 32 * nt + r32) * 136 + 16 * ks + 8 * hi);
                acc[mt][nt] = __builtin_amdgcn_mfma_f32_32x32x16_bf16(bfr, af[mt][ks], acc[mt][nt], 0, 0, 0);
            }
#pragma unroll
    for (int mt = 0; mt < 2; ++mt) {
        const int tt = 64 * rh + 32 * mt + r32;
        const float bias = biasv[mt];
#pragma unroll
        for (int nt = 0; nt < 2; ++nt)
#pragma unroll
            for (int rg = 0; rg < 4; ++rg) {
                const int col = g * 64 + 32 * nt + 8 * rg + 4 * hi;
                const f32x4 gn = gnv[nt][rg];
                const u32x2 uv = uu[mt][nt][rg];
                const float o0 = __uint_as_float(uv.x << 16) * (gn[0] * acc[mt][nt][4 * rg + 0] + bias);
                const float o1 = __uint_as_float(uv.x & 0xffff0000u) * (gn[1] * acc[mt][nt][4 * rg + 1] + bias);
                const float o2 = __uint_as_float(uv.y << 16) * (gn[2] * acc[mt][nt][4 * rg + 2] + bias);
                const float o3 = __uint_as_float(uv.y & 0xffff0000u) * (gn[3] * acc[mt][nt][4 * rg + 3] + bias);
                u32x2 w; w.x = pk_bf16(o0, o1); w.y = pk_bf16(o2, o3);
                *(u32x2*)(MIX + (size_t)(s0 + tt) * DM + 512 + col) = w;
            }
    }
    __syncthreads();
}

constexpr int AT_KSTR = 208, AT_VSTR = 192, AT_KB = 64 * AT_KSTR, AT_VB = 64 * AT_VSTR;
constexpr float ATT_THR = 8.0f;
#define MX3(a, b, c) __builtin_fmaxf(__builtin_fmaxf((a), (b)), (c))
typedef __bf16 bf16x2_t __attribute__((ext_vector_type(2)));
__device__ __forceinline__ unsigned pk2(float lo, float hi) { f32x2 v = {lo, hi}; bf16x2_t b = __builtin_convertvector(v, bf16x2_t); return __builtin_bit_cast(unsigned, b); }
__device__ __forceinline__ float rowmax32(const f32x16& a, const f32x16& b) {
    float x = MX3(a[0], a[1], b[0]), y = MX3(a[2], a[3], b[1]); x = MX3(x, b[2], b[3]);
#pragma unroll
    for (int r = 4; r < 16; r += 4) { x = MX3(x, a[r], a[r + 1]); y = MX3(y, a[r + 2], a[r + 3]); x = MX3(x, b[r], b[r + 1]); y = MX3(y, b[r + 2], b[r + 3]); }
    return swap32_max(__builtin_fmaxf(x, y));
}
__device__ __forceinline__ void attn_kload(bf16x8 (&kf)[12], const LAS unsigned char* Ks, int r32, int hi) {
#pragma unroll
    for (int d0 = 0; d0 < 6; ++d0) {
        kf[2 * d0] = *(const LAS bf16x8*)(Ks + r32 * AT_KSTR + d0 * 32 + hi * 16);
        kf[2 * d0 + 1] = *(const LAS bf16x8*)(Ks + (32 + r32) * AT_KSTR + d0 * 32 + hi * 16);
    }
}
__device__ __forceinline__ void attn_qk(f32x16& s0, f32x16& s1, const bf16x8 (&kf)[12], const bf16x8 (&qf)[6], const f32x16& negm) {
#pragma unroll
    for (int d0 = 0; d0 < 6; ++d0) {
        if (d0 == 0) { s0 = __builtin_amdgcn_mfma_f32_32x32x16_bf16(kf[0], qf[0], negm, 0, 0, 0); s1 = __builtin_amdgcn_mfma_f32_32x32x16_bf16(kf[1], qf[0], negm, 0, 0, 0); }
        else { s0 = __builtin_amdgcn_mfma_f32_32x32x16_bf16(kf[2 * d0], qf[d0], s0, 0, 0, 0); s1 = __builtin_amdgcn_mfma_f32_32x32x16_bf16(kf[2 * d0 + 1], qf[d0], s1, 0, 0, 0); }
    }
}
__device__ __forceinline__ void attn_mask(f32x16& s0, f32x16& s1, int jb, int qrel, int hi) {
#pragma unroll
    for (int r = 0; r < 16; ++r) {
        const int kv = 64 * jb + crow(r, hi);
        if (kv > qrel) s0[r] = -INFINITY;
        if (kv + 32 > qrel) s1[r] = -INFINITY;
    }
}
__device__ __forceinline__ void attn_unit(LAS unsigned char* lds, const bf16_t* __restrict__ Qb, const bf16_t* __restrict__ KN, const bf16_t* __restrict__ Pb,
                                          const bf16_t* __restrict__ Vb, bf16_t* __restrict__ MIX, int h, int qb) {
    int tid_l = threadIdx.x; asm volatile("" : "+v"(tid_l)); const int tid = tid_l, lane = tid & 63, wid = __builtin_amdgcn_readfirstlane(tid >> 6), r32 = lane & 31, hi = lane >> 5;
    const int qrow = qb * 256 + wid * 32 + r32, qrel = 32 * wid + r32;
    bf16x8 qf[6];
    {
        const bf16_t* qp = Qb + (size_t)qrow * QW;
#pragma unroll
        for (int d0 = 0; d0 < 4; ++d0) qf[d0] = *(const bf16x8*)(qp + h * 64 + d0 * 16 + hi * 8);
#pragma unroll
        for (int d0 = 4; d0 < 6; ++d0) qf[d0] = *(const bf16x8*)(qp + 512 + h * 32 + (d0 - 4) * 16 + hi * 8);
    }
    const int NT = 4 * qb + 4;
    const int ra = tid / 12, pa = tid - ra * 12;
    const int cb = 512 + tid, rb = cb / 12, pb = cb - rb * 12;
    const bf16_t* srcA = pa < 8 ? KN + (size_t)ra * 512 + h * 64 + pa * 8 : Pb + (size_t)ra * PW + P_KR + (pa - 8) * 8;
    const size_t strA = pa < 8 ? (size_t)64 * 512 : (size_t)64 * PW;
    const bf16_t* srcB = pb < 8 ? KN + (size_t)rb * 512 + h * 64 + pb * 8 : Pb + (size_t)rb * PW + P_KR + (pb - 8) * 8;
    const size_t strB = pb < 8 ? (size_t)64 * 512 : (size_t)64 * PW;
    const bf16_t* srcV = Vb + (size_t)(tid >> 3) * 512 + h * 64 + (tid & 7) * 8;
    const int dstA = ra * AT_KSTR + pa * 16, dstB = rb * AT_KSTR + pb * 16, dstV = 4 * AT_KB + (tid >> 3) * AT_VSTR + (tid & 7) * 16;
    const bool hasB = tid < 256;
    u32x4 ga, gb = (u32x4){0u, 0u, 0u, 0u}, gv, ha, hb = (u32x4){0u, 0u, 0u, 0u}, hv;
    {
        const u32x4 k0a = *(const u32x4*)srcA, k1a = *(const u32x4*)(srcA + strA), k2a = *(const u32x4*)(srcA + 2 * strA);
        const u32x4 v0 = *(const u32x4*)srcV, v1 = *(const u32x4*)(srcV + (size_t)64 * 512);
        u32x4 k0b = gb, k1b = gb, k2b = gb;
        if (hasB) { k0b = *(const u32x4*)srcB; k1b = *(const u32x4*)(srcB + strB); k2b = *(const u32x4*)(srcB + 2 * strB); }
        *(LAS u32x4*)(lds + dstA) = k0a; *(LAS u32x4*)(lds + AT_KB + dstA) = k1a; *(LAS u32x4*)(lds + 2 * AT_KB + dstA) = k2a;
        *(LAS u32x4*)(lds + dstV) = v0; *(LAS u32x4*)(lds + AT_VB + dstV) = v1;
        if (hasB) { *(LAS u32x4*)(lds + dstB) = k0b; *(LAS u32x4*)(lds + AT_KB + dstB) = k1b; *(LAS u32x4*)(lds + 2 * AT_KB + dstB) = k2b; }
    }
    __syncthreads();
    float mref = 0.f, lrun = 0.f, mxc;
    f32x16 o0, o1, negm, sA0, sA1, sB0, sB1;
#pragma unroll
    for (int r = 0; r < 16; ++r) { o0[r] = 0.f; o1[r] = 0.f; negm[r] = 0.f; }
    const int i16 = lane & 15, vq = i16 >> 2, vp = i16 & 3, vblk = (lane >> 4) & 1;
    const int voff = 4 * AT_KB + (4 * hi + vq) * AT_VSTR + vblk * 32 + vp * 8;
    { bf16x8 kf0[12]; attn_kload(kf0, lds, r32, hi); attn_qk(sA0, sA1, kf0, qf, negm); }
    if (qb == 0) attn_mask(sA0, sA1, 0, qrel, hi);
    mref = rowmax32(sA0, sA1);
#pragma unroll
    for (int r = 0; r < 16; ++r) { sA0[r] -= mref; sA1[r] -= mref; negm[r] = -mref; }
    mxc = 0.f;
    __syncthreads();
#define ATT_STEP(C0, C1, N0, N1, T) do { \
        const int t_ = (T); \
        if (__any(mxc > ATT_THR)) { \
            const float dl = fmaxf(mxc, 0.f); mref += dl; const float al = __builtin_amdgcn_exp2f(-dl); lrun *= al; \
            _Pragma("unroll") for (int r = 0; r < 16; ++r) { C0[r] -= dl; C1[r] -= dl; negm[r] = -mref; o0[r] *= al; o1[r] *= al; } \
        } \
        const LAS unsigned char* Kn = lds + ((t_ + 1) & 3) * AT_KB; \
        bf16x8 kf[12]; attn_kload(kf, Kn, r32, hi); \
        __builtin_amdgcn_sched_barrier(0); \
        attn_qk(N0, N1, kf, qf, negm); \
        float ps0 = 0.f, ps1 = 0.f, ps2 = 0.f, ps3 = 0.f; \
        _Pragma("unroll") for (int r = 0; r < 16; r += 2) { C0[r] = __builtin_amdgcn_exp2f(C0[r]); C1[r] = __builtin_amdgcn_exp2f(C1[r]); C0[r + 1] = __builtin_amdgcn_exp2f(C0[r + 1]); C1[r + 1] = __builtin_amdgcn_exp2f(C1[r + 1]); \
            ps0 += C0[r]; ps1 += C1[r]; ps2 += C0[r + 1]; ps3 += C1[r + 1]; } \
        lrun += (ps0 + ps1) + (ps2 + ps3); \
        bf16x8 pf[4]; \
        _Pragma("unroll") for (int ks = 0; ks < 2; ++ks) { \
            u32x4 w0, w1; \
            w0.x = pk2(C0[8 * ks + 0], C0[8 * ks + 1]); w0.y = pk2(C0[8 * ks + 2], C0[8 * ks + 3]); w0.z = pk2(C0[8 * ks + 4], C0[8 * ks + 5]); w0.w = pk2(C0[8 * ks + 6], C0[8 * ks + 7]); \
            w1.x = pk2(C1[8 * ks + 0], C1[8 * ks + 1]); w1.y = pk2(C1[8 * ks + 2], C1[8 * ks + 3]); w1.z = pk2(C1[8 * ks + 4], C1[8 * ks + 5]); w1.w = pk2(C1[8 * ks + 6], C1[8 * ks + 7]); \
            asm volatile("" : "+v"(w0), "+v"(w1)); \
            pf[ks] = __builtin_bit_cast(bf16x8, w0); pf[2 + ks] = __builtin_bit_cast(bf16x8, w1); } \
        asm volatile("" : "+v"(lrun)); \
        _Pragma("unroll") for (int i_ = 0; i_ < 12; ++i_) { __builtin_amdgcn_sched_group_barrier(0x008, 1, 0); __builtin_amdgcn_sched_group_barrier(0x002, 7, 0); } \
        __builtin_amdgcn_sched_barrier(0); \
        const LAS unsigned char* Vs = lds + voff + (t_ & 3) * AT_VB; \
        s16x4 vlo[8], vhi[8]; \
        _Pragma("unroll") for (int ks = 0; ks < 4; ++ks) { \
            _Pragma("unroll") for (int db = 0; db < 2; ++db) { \
                const LAS unsigned char* vp0 = Vs + ks * 16 * AT_VSTR + db * 64; \
                vlo[ks * 2 + db] = __builtin_bit_cast(s16x4, __builtin_amdgcn_ds_read_tr16_b64_v4i16((LAS s16x4*)vp0)); \
                vhi[ks * 2 + db] = __builtin_bit_cast(s16x4, __builtin_amdgcn_ds_read_tr16_b64_v4i16((LAS s16x4*)(vp0 + 8 * AT_VSTR))); } } \
        if (t_ + 1 >= 4 * qb) attn_mask(N0, N1, t_ + 1 - 4 * qb, qrel, hi); \
        __builtin_amdgcn_sched_barrier(0); \
        _Pragma("unroll") for (int ks = 0; ks < 4; ++ks) { \
            _Pragma("unroll") for (int db = 0; db < 2; ++db) { \
                const s16x4 lo = vlo[ks * 2 + db], hh = vhi[ks * 2 + db]; \
                const bf16x8 vf = (bf16x8){lo[0], lo[1], lo[2], lo[3], hh[0], hh[1], hh[2], hh[3]}; \
                if (db == 0) o0 = __builtin_amdgcn_mfma_f32_32x32x16_bf16(vf, pf[ks], o0, 0, 0, 0); \
                else o1 = __builtin_amdgcn_mfma_f32_32x32x16_bf16(vf, pf[ks], o1, 0, 0, 0); } } \
        mxc = rowmax32(N0, N1); \
        _Pragma("unroll") for (int i_ = 0; i_ < 8; ++i_) { __builtin_amdgcn_sched_group_barrier(0x008, 1, 1); __builtin_amdgcn_sched_group_barrier(0x002, 3, 1); } \
        __builtin_amdgcn_sched_barrier(0); \
    } while (0)
    for (int t = 0; t < NT; t += 2) {
        const bool m3 = (t + 3 < NT), m4 = (t + 4 < NT), v2 = (t + 2 < NT);
        if (m3) { ga = *(const u32x4*)(srcA + (size_t)(t + 3) * strA); if (hasB) gb = *(const u32x4*)(srcB + (size_t)(t + 3) * strB); hv = *(const u32x4*)(srcV + (size_t)(t + 3) * 64 * 512); }
        if (m4) { ha = *(const u32x4*)(srcA + (size_t)(t + 4) * strA); if (hasB) hb = *(const u32x4*)(srcB + (size_t)(t + 4) * strB); }
        if (v2) gv = *(const u32x4*)(srcV + (size_t)(t + 2) * 64 * 512);
        ATT_STEP(sA0, sA1, sB0, sB1, t);
        ATT_STEP(sB0, sB1, sA0, sA1, t + 1);
        if (m3) { LAS unsigned char* kd = lds + ((t + 3) & 3) * AT_KB; *(LAS u32x4*)(kd + dstA) = ga; if (hasB) *(LAS u32x4*)(kd + dstB) = gb; *(LAS u32x4*)(lds + ((t + 3) & 3) * AT_VB + dstV) = hv; }
        if (m4) { LAS unsigned char* kd = lds + ((t + 4) & 3) * AT_KB; *(LAS u32x4*)(kd + dstA) = ha; if (hasB) *(LAS u32x4*)(kd + dstB) = hb; }
        if (v2) *(LAS u32x4*)(lds + ((t + 2) & 3) * AT_VB + dstV) = gv;
        __syncthreads();
    }
#undef ATT_STEP
    const float inv = 1.0f / swap32_sum(lrun);
    bf16_t* op = MIX + (size_t)qrow * DM + h * 64 + 4 * hi;
#pragma unroll
    for (int rg = 0; rg < 4; ++rg) {
        u32x2 w0, w1;
        w0.x = pk_bf16(o0[4 * rg] * inv, o0[4 * rg + 1] * inv); w0.y = pk_bf16(o0[4 * rg + 2] * inv, o0[4 * rg + 3] * inv);
        w1.x = pk_bf16(o1[4 * rg] * inv, o1[4 * rg + 1] * inv); w1.y = pk_bf16(o1[4 * rg + 2] * inv, o1[4 * rg + 3] * inv);
        *(u32x2*)(op + 8 * rg) = w0; *(u32x2*)(op + 32 + 8 * rg) = w1;
    }
}

__global__ void __launch_bounds__(NTHREADS, 2) mega_fwd(Params p) {
    extern __shared__ __attribute__((aligned(16))) unsigned char lds_raw[];
    LAS unsigned char* lds = (LAS unsigned char*)lds_raw;
    cg::grid_group grid = cg::this_grid();
    const int G = gridDim.x, bid = blockIdx.x;
    const int ngw = G * NWAVES;
#define LAUNDER_TID() int tid_l = threadIdx.x; asm volatile("" : "+v"(tid_l)); const int tid = tid_l, lane = tid & 63, wave = __builtin_amdgcn_readfirstlane(tid >> 6), gw = bid * NWAVES + wave; (void)tid; (void)lane; (void)gw;
    unsigned char* ws = p.ws;
    float* ssb = (float*)(ws + OFF_SS);
    bf16_t* XB = (bf16_t*)(ws + OFF_XB);
    const float* cs = (const float*)(ws + OFF_ROPE); const float* sn = cs + S * 16;
    int st = 0;
    const int lo = p.step_lo, hi_ = p.step_hi;
    const bool single = (lo == 0 && hi_ >= 1000);
#define RUN (st >= lo && st < hi_)
#define SYNC() do { if (single) xcd_barrier(xbar); ++st; } while (0)

    volatile LAS unsigned* xst = (volatile LAS unsigned*)(lds + LDS_MISC);
    if (threadIdx.x < 2) xst[threadIdx.x] = 0u;
    __syncthreads();
    XcdBarrier xbar; xbar.bar = (unsigned*)(ws + OFF_BAR); xbar.x = 0; xbar.st = xst;
    if (single) xbar = xcd_barrier_post((unsigned*)(ws + OFF_BAR), xst);
    if (p.step_hi < 0) grid.sync();
    if (RUN) { LAUNDER_TID(); prologue(p, lds, gw, ngw, lane, wave); }
    if (single) xcd_barrier(xbar);
    ++st;

    for (int l = 0; l < 4; ++l) {
        for (int sub = 0; sub < 3; ++sub) {
            const bool is_ffn = (sub != 1), even = ((l & 1) == 0);
            const int e = l >> 1;
            const int kin = l * 3 + sub;
            float* ss_in = ssb + (size_t)kin * S * 16; float* ss_out = ssb + (size_t)(kin + 1) * S * 16;
            float* ss_cq = ssb + (size_t)(13 + 3 * e) * S * 16; float* ss_ckv = ss_cq + (size_t)S * 16; float* ss_v = ss_ckv + (size_t)S * 16;
            if (is_ffn || !even) {
                if (RUN) {
                    pg8::Gemm g; pg8::StaticOrder So; EpiPair E;
                    g.A = XB; g.M = S; g.K = DM; g.lda = DM; g.ldb = DM;
                    if (is_ffn) { g.Bt = (const bf16_t*)(ws + OFF_WGU) + (size_t)(2 * l + (sub == 2)) * NGU * DM; g.N = NGU; E.O = (bf16_t*)(ws + OFF_ACT); E.ldo = FF; E.mode = 0; }
                    else { g.Bt = (const bf16_t*)(ws + OFF_WCIN) + (size_t)e * 3072 * DM; g.N = 2048; E.O = (bf16_t*)(ws + OFF_CZ); E.ldo = DM; E.mode = 1; }
                    E.ss = ss_in; E.inv_dim = 1.0f / DM;
                    So.init(S, g.N, G, bid);
                    pg8::gemm_phase<EpiPair, pg8::StaticOrder, true, true>(lds, g, So, E);
                    if (is_ffn) {
                        const int nfull = (64 * 22) % G, nwk = nfull ? G - nfull : G, wk = nfull ? bid - nfull : bid;
                        if (wk >= 0) {
                            LAUNDER_TID();
                            int a0, a1, b0 = 0, b1 = 0;
                            if (sub == 0) { a0 = 6 * l + 3; a1 = 6 * l + 6; if (l == 0) { b0 = 24; b1 = 28; } }
                            else if (l < 3) { const int ln = l + 1; a0 = 6 * ln; a1 = 6 * ln + 3; if (ln & 1) { b0 = 32 + 2 * (ln >> 1); b1 = b0 + 2; } else { b0 = 24 + 4 * (ln >> 1); b1 = b0 + 4; } }
                            else { a0 = 0; a1 = 0; }
                            convert_jobs(p, lds, a0, a1, wk * NWAVES + wave, nwk * NWAVES, lane, wave);
                            convert_jobs(p, lds, b0, b1, wk * NWAVES + wave, nwk * NWAVES, lane, wave);
                        }
                    }
                }
            }
            if (!is_ffn) {
                const int ng = even ? 3 : 1;
                for (int gi = 0; gi < ng; ++gi) {
                    if (RUN) {
                        pg8::Gemm g; pg8::StaticOrder So; EpiRow E;
                        g.M = S; E.split_tiles = 0; E.split_stride = 0; E.gelu_from = 1 << 20; E.rope_pn = -1; E.rope_bj = -1; E.rope_wc = 0; E.cs = cs; E.sn = sn;
                        E.stat_map = 0ull; E.stb = ss_cq;
                        if (!even) {
                            g.A = XB; g.lda = DM; g.K = DM; g.ldb = DM; g.Bt = (const bf16_t*)(ws + OFF_WCIN) + (size_t)e * 3072 * DM + (size_t)2048 * DM; g.N = 1024;
                            E.O = (bf16_t*)(ws + OFF_BG); E.ldo = DM; E.ss = ss_in; E.inv_dim = 1.0f / DM; E.nsl = 16;
                        } else if (gi == 0) {
                            g.A = XB; g.lda = DM; g.K = DM; g.ldb = DM; g.Bt = (const bf16_t*)(ws + OFF_WIN) + (size_t)e * PW * DM; g.N = PW;
                            E.O = (bf16_t*)(ws + OFF_P); E.ldo = PW; E.ss = ss_in; E.inv_dim = 1.0f / DM; E.nsl = 16;
                            E.gelu_from = 3; E.rope_pn = 2; E.rope_bj = 1; E.rope_wc = 0;
                            E.stat_map = 0x1ull | (0x1ull << 4) | (0x1ull << 8) | (0x2ull << 12) | (0x2ull << 16) | (0x3ull << 40) | (0x3ull << 44) | (0x3ull << 48) | (0x3ull << 52);
                        } else if (gi == 1) {
                            g.A = (const bf16_t*)(ws + OFF_P) + P_CKV; g.lda = PW; g.K = 256; g.ldb = 256; g.Bt = (const bf16_t*)(ws + OFF_WUKV) + (size_t)e * 1024 * 256; g.N = 1024;
                            E.O = (bf16_t*)(ws + OFF_KN); E.ldo = 512; E.split_tiles = 2; E.split_stride = (OFF_V - OFF_KN) / 2; E.ss = ss_ckv; E.inv_dim = 1.0f / 256.0f; E.nsl = 8;
                        } else {
                            g.A = (const bf16_t*)(ws + OFF_P) + P_CQ; g.lda = PW; g.K = 384; g.ldb = 384; g.Bt = (const bf16_t*)(ws + OFF_WUQ) + (size_t)e * 768 * 384; g.N = 768;
                            E.O = (bf16_t*)(ws + OFF_Q); E.ldo = QW; E.ss = ss_cq; E.inv_dim = 1.0f / 384.0f; E.nsl = 12; E.rope_pn = 2; E.rope_bj = -1;
                        }
                        So.init(S, g.N, G, bid);
                        pg8::gemm_phase<EpiRow, pg8::StaticOrder, true, true>(lds, g, So, E);
                    }
                    if (even && gi == 0) SYNC();
                }
            }
            SYNC();
            if (!is_ffn) {
                if (RUN) {
                    if (even) {
                        const bf16_t* P = (const bf16_t*)(ws + OFF_P);
                        bf16_t* MIX = (bf16_t*)(ws + OFF_MIX);
                        for (int u = bid; u < 256; u += G)
                            sgu_unit(lds, u, P, ss_v, (const bf16_t*)(ws + OFF_WSG) + (size_t)e * 8 * 128 * 128, p.in[18] + (size_t)e * 8 * 128, p.in[16] + (size_t)e * 512, MIX);
                        for (int u = bid; u < 256; u += G) {
                            const int h = u & 7, s = u >> 3;
                            attn_unit(lds, (const bf16_t*)(ws + OFF_Q), (const bf16_t*)(ws + OFF_KN), P, (const bf16_t*)(ws + OFF_V), MIX, h, 63 - s);
                            attn_unit(lds, (const bf16_t*)(ws + OFF_Q), (const bf16_t*)(ws + OFF_KN), P, (const bf16_t*)(ws + OFF_V), MIX, h, s);
                        }
                    } else {
                        const bf16_t* CZ = (const bf16_t*)(ws + OFF_CZ); const bf16_t* BG = (const bf16_t*)(ws + OFF_BG); bf16_t* Gb = (bf16_t*)(ws + OFF_G);
                        const float* cw = p.in[21] + (size_t)e * 3 * DM;
                        LAUNDER_TID();
                        for (int idx = bid * NTHREADS + tid; idx < S * 128; idx += G * NTHREADS) {
                            const int t = idx >> 7, c8 = (idx & 127) * 8;
                            const u32x4 z0 = *(const u32x4*)(CZ + (size_t)t * DM + c8);
                            const u32x4 z1 = t >= 1 ? *(const u32x4*)(CZ + (size_t)(t - 1) * DM + c8) : (u32x4){0u, 0u, 0u, 0u};
                            const u32x4 z2 = t >= 2 ? *(const u32x4*)(CZ + (size_t)(t - 2) * DM + c8) : (u32x4){0u, 0u, 0u, 0u};
                            const u32x4 bg = *(const u32x4*)(BG + (size_t)t * DM + c8);
                            float o[8];
#pragma unroll
                            for (int i = 0; i < 4; ++i) {
#pragma unroll
                                for (int hlf = 0; hlf < 2; ++hlf) {
                                    const int c = c8 + 2 * i + hlf;
                                    const float a0 = hlf ? __uint_as_float(z0[i] & 0xffff0000u) : __uint_as_float(z0[i] << 16);
                                    const float a1 = hlf ? __uint_as_float(z1[i] & 0xffff0000u) : __uint_as_float(z1[i] << 16);
                                    const float a2 = hlf ? __uint_as_float(z2[i] & 0xffff0000u) : __uint_as_float(z2[i] << 16);
                                    const float bb = hlf ? __uint_as_float(bg[i] & 0xffff0000u) : __uint_as_float(bg[i] << 16);
                                    o[2 * i + hlf] = bb * (cw[c] * a2 + cw[DM + c] * a1 + cw[2 * DM + c] * a0);
                                }
                            }
                            u32x4 w; w.x = pk_bf16(o[0], o[1]); w.y = pk_bf16(o[2], o[3]); w.z = pk_bf16(o[4], o[5]); w.w = pk_bf16(o[6], o[7]);
                            *(u32x4*)(Gb + (size_t)t * DM + c8) = w;
                        }
                    }
                }
                SYNC();
            }
            if (RUN) {
                pg8::Gemm g; pg8::StaticOrder So; EpiRes E;
                g.M = S; g.N = DM;
                if (is_ffn) { g.A = (const bf16_t*)(ws + OFF_ACT); g.K = FF; g.lda = FF; g.ldb = FF; g.Bt = (const bf16_t*)(ws + OFF_WD) + (size_t)(2 * l + (sub == 2)) * DM * FF; E.alpha = 0.5f; }
                else if (even) { g.A = (const bf16_t*)(ws + OFF_MIX); g.K = DM; g.lda = DM; g.ldb = DM; g.Bt = (const bf16_t*)(ws + OFF_WOUT) + (size_t)e * DM * DM; E.alpha = 1.0f; }
                else { g.A = (const bf16_t*)(ws + OFF_G); g.K = DM; g.lda = DM; g.ldb = DM; g.Bt = (const bf16_t*)(ws + OFF_WCOUT) + (size_t)e * DM * DM; E.alpha = 1.0f; }
                E.XB = XB; E.ss_out = ss_out;
                So.init(S, DM, G, bid);
                pg8::gemm_phase<EpiRes, pg8::StaticOrder, true, true>(lds, g, So, E);
            }
            SYNC();
        }
    }
    if (RUN) {
        const float* gn = p.in[23];
        LAUNDER_TID();
        for (int row = gw; row < S; row += ngw) {
            const u32x2* xr = (const u32x2*)(XB + (size_t)row * DM) + lane;
            f32x4 v[4]; float s = 0.f;
#pragma unroll
            for (int j = 0; j < 4; ++j) {
                const u32x2 w = xr[64 * j];
                v[j] = (f32x4){__uint_as_float(w.x << 16), __uint_as_float(w.x & 0xffff0000u), __uint_as_float(w.y << 16), __uint_as_float(w.y & 0xffff0000u)};
                s += (v[j][0] * v[j][0] + v[j][1] * v[j][1]) + (v[j][2] * v[j][2] + v[j][3] * v[j][3]);
            }
#pragma unroll
            for (int o = 1; o < 64; o <<= 1) s += __shfl_xor(s, o);
            const float rs = rsqrtf(s * (1.0f / DM) + EPS);
            f32x4* orow = (f32x4*)(p.out + (size_t)row * DM) + lane;
#pragma unroll
            for (int j = 0; j < 4; ++j) { const f32x4 gg = ((const f32x4*)gn + lane)[64 * j]; orow[64 * j] = v[j] * rs * gg; }
        }
    }
#undef RUN
#undef SYNC
}

#ifndef MK_MULTI
#define MK_MULTI 0
#endif
extern "C" void kernel_launch(void* const* d_in, const int* in_sizes, int n_in, void* d_out, int out_size, void* d_ws, size_t ws_size, hipStream_t stream) {
    static int grid = 0;
    if (grid == 0) {
        if (n_in != 24 || out_size != S * DM || ws_size < WS_END) { fprintf(stderr, "kernel_launch: unexpected problem (n_in %d out %d ws %zu)\n", n_in, out_size, ws_size); grid = -1; return; }
        int dev = 0, cus = 0, per_cu = 0;
        hipGetDevice(&dev);
        hipDeviceGetAttribute(&cus, hipDeviceAttributeMultiprocessorCount, dev);
        if (hipFuncSetAttribute((const void*)mega_fwd, hipFuncAttributeMaxDynamicSharedMemorySize, LDS_BYTES) != hipSuccess) { fprintf(stderr, "hipFuncSetAttribute failed\n"); grid = -1; return; }
        if (hipOccupancyMaxActiveBlocksPerMultiprocessor(&per_cu, (const void*)mega_fwd, NTHREADS, LDS_BYTES) != hipSuccess || per_cu < 1) { fprintf(stderr, "occupancy query failed (%d)\n", per_cu); per_cu = 1; }
        (void)hipGetLastError();
        if (per_cu > 1) per_cu = 1;
        grid = cus * per_cu;
    }
    if (grid < 0) return;
    (void)hipMemsetAsync((char*)d_ws + OFF_BAR, 0, XCD_BAR_WORDS * sizeof(unsigned), stream);
    Params p{};
    for (int i = 0; i < 24; ++i) p.in[i] = (const float*)d_in[i];
    p.out = (float*)d_out; p.ws = (unsigned char*)d_ws;
    for (int i = 0; i < 16; ++i) p.inv_freq[i] = (float)pow(10000.0, -(double)i / 16.0);
#if MK_MULTI
    for (int s = 0; s < 40; ++s) {
        p.step_lo = s; p.step_hi = s + 1;
        hipLaunchKernelGGL(mega_fwd, dim3(grid), dim3(NTHREADS), LDS_BYTES, stream, p);
    }
#else
    p.step_lo = 0; p.step_hi = 1000;
    void* args[] = {&p};
    hipError_t e = hipLaunchCooperativeKernel((const void*)mega_fwd, dim3(grid), dim3(NTHREADS), args, LDS_BYTES, stream);
    if (e != hipSuccess) fprintf(stderr, "cooperative launch failed: %s (grid %d)\n", hipGetErrorString(e), grid);
#endif
}
```
